# Optimizing an MI355X kernel written in HIP

```python
import jax, jax.numpy as jnp
from jax import lax
import numpy as np

D_MODEL = 1024
BATCH = 4
SEQ = 8192
DEPTH = 1

CONV_CH = D_MODEL // 2
N_CONV_GROUPS = 8
HEAD_DIM = 64
N_HEADS = (D_MODEL // 2) // HEAD_DIM
ATTN_W = N_HEADS * HEAD_DIM
MIX_W = CONV_CH + ATTN_W
CONV_K = 3
D_FF = ((8 * D_MODEL) // 3 + 255) // 256 * 256
Q_BLOCK = 128
EPS = 1e-6
FORGET_BIAS_INIT = 3.0
IN_COLS = 3 * CONV_CH + 3 * ATTN_W + N_HEADS

kernel_name = "hymba_conv_fox_convffn_layer"


def rmsnorm(x, g):
    xf = x.astype(jnp.float32)
    y = xf * lax.rsqrt(jnp.mean(xf * xf, axis=-1, keepdims=True) + EPS)
    return (y * g.astype(jnp.float32)).astype(x.dtype)


def causal_dwconv(x, w):
    s = x.shape[1]
    xp = jnp.pad(x, ((0, 0), (CONV_K - 1, 0), (0, 0)))
    return sum(xp[:, j:j + s, :] * w[j] for j in range(CONV_K))


def fox_attention(q, k, v, log_f):
    b, s, h, dh = q.shape
    nblk = s // Q_BLOCK
    scale = 1.0 / np.sqrt(dh).astype(np.float32)
    F = jnp.transpose(jnp.cumsum(log_f, axis=1), (0, 2, 1))
    q_blocks = jnp.transpose(q.reshape(b, nblk, Q_BLOCK, h, dh), (1, 0, 2, 3, 4))
    f_blocks = jnp.transpose(F.reshape(b, h, nblk, Q_BLOCK), (2, 0, 1, 3))
    kpos = jnp.arange(s)

    def one_block(args):
        qb, fqb, i = args
        qpos = i * Q_BLOCK + jnp.arange(Q_BLOCK)
        sc = jnp.einsum('bqhd,bkhd->bhqk', qb, k,
                        preferred_element_type=jnp.float32) * scale
        logits = sc + fqb[..., None] - F[:, :, None, :]
        mask = kpos[None, :] <= qpos[:, None]
        logits = jnp.where(mask[None, None], logits, -jnp.inf)
        p = jax.nn.softmax(logits, axis=-1)
        return jnp.einsum('bhqk,bkhd->bqhd', p.astype(v.dtype), v)

    out = lax.map(one_block, (q_blocks, f_blocks, jnp.arange(nblk)))
    return jnp.transpose(out, (1, 0, 2, 3, 4)).reshape(b, s, h * dh)


def setup_inputs(seed: int = 0) -> dict:
    key = jax.random.key(seed)
    ks = jax.random.split(key, 16)
    nrm = lambda k, shape, sc: jax.random.normal(k, shape, jnp.float32) * sc
    gain = lambda k, shape: 1.0 + 0.02 * jax.random.normal(k, shape, jnp.float32)
    return {
        "x": jax.random.normal(ks[0], (BATCH, SEQ, D_MODEL), jnp.float32),
        "g_mix": gain(ks[1], (DEPTH, D_MODEL)),
        "w_in": nrm(ks[2], (DEPTH, D_MODEL, IN_COLS), D_MODEL ** -0.5),
        "b_f": FORGET_BIAS_INIT + 0.1 * jax.random.normal(ks[3], (DEPTH, N_HEADS), jnp.float32),
        "w_conv": nrm(ks[4], (DEPTH, CONV_K, CONV_CH), CONV_K ** -0.5),
        "g_conv_out": gain(ks[5], (DEPTH, CONV_CH)),
        "g_attn_out": gain(ks[6], (DEPTH, ATTN_W)),
        "w_o": nrm(ks[7], (DEPTH, MIX_W, D_MODEL), MIX_W ** -0.5),
        "g_ffn": gain(ks[8], (DEPTH, D_MODEL)),
        "w_up": nrm(ks[9], (DEPTH, D_MODEL, 2 * D_FF), D_MODEL ** -0.5),
        "w_ffn_conv": nrm(ks[10], (DEPTH, CONV_K, 2 * D_FF), CONV_K ** -0.5),
        "w_down": nrm(ks[11], (DEPTH, D_FF, D_MODEL), D_FF ** -0.5),
        "g_final": gain(ks[12], (D_MODEL,)),
    }


def reference(x, g_mix, w_in, b_f, w_conv, g_conv_out, g_attn_out, w_o,
              g_ffn, w_up, w_ffn_conv, w_down, g_final):
    b, s, _ = x.shape
    o1 = CONV_CH
    o2 = 2 * CONV_CH
    o3 = 3 * CONV_CH
    o4 = o3 + ATTN_W
    o5 = o4 + ATTN_W
    o6 = o5 + ATTN_W
    for l in range(DEPTH):
        h = rmsnorm(x, g_mix[l])
        z = h @ w_in[l]
        gb, gc, xc = z[..., :o1], z[..., o1:o2], z[..., o2:o3]
        q = z[..., o3:o4].reshape(b, s, N_HEADS, HEAD_DIM)
        k = z[..., o4:o5].reshape(b, s, N_HEADS, HEAD_DIM)
        v = z[..., o5:o6].reshape(b, s, N_HEADS, HEAD_DIM)
        f_logit = z[..., o6:]
        y_conv = gb * causal_dwconv(gc * xc, w_conv[l])
        log_f = jax.nn.log_sigmoid((f_logit + b_f[l]).astype(jnp.float32))
        y_attn = fox_attention(q, k, v, log_f)
        mix = jnp.concatenate([rmsnorm(y_conv, g_conv_out[l]),
                               rmsnorm(y_attn, g_attn_out[l])], axis=-1)
        x = x + mix @ w_o[l]
        h = rmsnorm(x, g_ffn[l])
        u = causal_dwconv(h @ w_up[l], w_ffn_conv[l])
        a, g = u[..., :D_FF], u[..., D_FF:]
        x = x + (jax.nn.silu(g) * a) @ w_down[l]
    return rmsnorm(x, g_final)
```

```cpp
#include <hip/hip_runtime.h>
#include <hip/hip_bf16.h>
#include <cstdio>
#include <cstdint>
#include <cmath>

#ifndef MEGA_MASK
#define MEGA_MASK 0x7F
#endif

constexpr int BATCH = 4, SEQ = 8192, DMODEL = 1024, TOK = BATCH * SEQ;
constexpr int CONV_CH = 512, NHEADS = 8, HEAD_DIM = 64, ATTN_W = 512, DFF = 2816, IN_COLS = 3080, NMAIN = 3072;
constexpr float RMS_EPS = 1e-6f;
constexpr float LOG2E = 1.4426950408889634f;
constexpr float QSCALE = 0.125f * LOG2E;

constexpr size_t MiB = 1u << 20;
constexpr size_t WS_CTL = 0, CTL_ZERO_BYTES = 1 * MiB;
constexpr size_t WS_WIN = 2 * MiB;
constexpr size_t WS_WO = 8 * MiB;
constexpr size_t WS_WUP = 10 * MiB;
constexpr size_t WS_WDN = 21 * MiB;
constexpr size_t WS_FB = 27 * MiB;
constexpr size_t WS_LOGF = 28 * MiB;
constexpr size_t WS_SSQA = 29 * MiB;
constexpr size_t WS_SSQ1 = 30 * MiB;
constexpr size_t WS_SSQ2 = 32 * MiB;
constexpr size_t WS_HF = 34 * MiB;
constexpr size_t WS_HL = 56 * MiB;
constexpr size_t WS_H1 = 80 * MiB;
constexpr size_t WS_QKV = 144 * MiB;
constexpr size_t QKV_STRIDE = 32 * MiB;
constexpr size_t WS_ACT = 144 * MiB;
constexpr size_t WS_MIX = 336 * MiB;
constexpr size_t WS_UU = 400 * MiB;
constexpr size_t WS_RS = 496 * MiB;
constexpr size_t WS_END = 500 * MiB;
static_assert(WS_WUP + (size_t)2 * DFF * DMODEL * 2 <= WS_WDN && WS_WDN + (size_t)DMODEL * DFF * 2 <= WS_FB && WS_HF + (size_t)512 * 2 * 2 * DFF * 4 <= WS_HL && WS_HL + (size_t)512 * 2 * 2 * DFF * 4 <= WS_H1, "d_ws map");
static_assert(WS_ACT + (size_t)TOK * DFF * 2 <= WS_MIX && WS_UU + (size_t)SEQ * 2 * DFF * 2 <= WS_RS, "d_ws map");
constexpr int CW_TMO = 0, CW_CODE = 1;
constexpr int CW_BAR = 4096;

namespace pg8 {
#define PG8_LAS __attribute__((address_space(3)))
typedef unsigned short bf16_t;
typedef short bf16x8 __attribute__((ext_vector_type(8)));
typedef float f32x4 __attribute__((ext_vector_type(4)));
typedef unsigned u32x4 __attribute__((ext_vector_type(4)));
constexpr int BM = 256, BK = 64, HALF = 128, HTB = HALF * BK * 2  , STAGE_BYTES = 8 * HTB, NXCD = 8, WGM = 8;

__host__ __device__ __forceinline__ int lds_byte(int r, int c) { const int st = (r >> 4) * 2 + (c >> 5), rr = r & 15, cc = c & 31, ob = rr * 64 + cc * 2; return st * 1024 + (ob ^ (((ob >> 9) & 1) << 5)); }
__host__ __device__ __forceinline__ void stage_rc(int b, int& R, int& C) { const int st = b / 1024, sb = b % 1024, swz = sb ^ (((sb >> 9) & 1) << 5); R = (st >> 1) * 16 + swz / 64; C = (st & 1) * 32 + (swz % 64) / 2; }
__host__ __device__ __forceinline__ int perm32(int rho) { const int n = rho >> 4, i = rho & 15; return 8 * (i >> 2) + 4 * n + (i & 3); }

struct Unit { int pm, pn; };
struct Gemm { const bf16_t* A; const bf16_t* Bt; int M, N, K; };

struct StaticOrder {
    int nM, nN, nwg, G, c;
    __host__ __device__ void init(int M, int N, int G_, int c_) { nM = M / BM; nN = N / BM; nwg = nM * nN; G = G_; c = c_; }
    __host__ __device__ bool next(int i, Unit& u) const {
        const long L = (long)i * G + c; if (L >= nwg) return false;
        int wgid = (int)L; { const int q = nwg / NXCD, r = nwg % NXCD, xcd = wgid % NXCD, off = wgid / NXCD; wgid = (xcd < r ? xcd * (q + 1) : r * (q + 1) + (xcd - r) * q) + off; }
        const int nig = WGM * nN, gid = wgid / nig, fm = gid * WGM, gsz = (nM - fm) < WGM ? (nM - fm) : WGM;
        u.pm = fm + ((wgid % nig) % gsz); u.pn = (wgid % nig) / gsz; return true;
    }
    __device__ __forceinline__ void a_ready(const Unit&) const {}
    __device__ __forceinline__ void done(const Unit&) const {}
};


__device__ __forceinline__ unsigned cvt_pk_bf16(float lo, float hi) { unsigned r; asm volatile("v_cvt_pk_bf16_f32 %0, %1, %2" : "=v"(r) : "v"(lo), "v"(hi)); return r; }
typedef unsigned u32x2 __attribute__((ext_vector_type(2)));
template <int CTRL> __device__ __forceinline__ float dpp_mov(float old, float src) {
    return __builtin_bit_cast(float, __builtin_amdgcn_update_dpp(__builtin_bit_cast(int, old), __builtin_bit_cast(int, src), CTRL, 0xf, 0xf, false)); }
constexpr int DPP_SHR1 = 0x111, DPP_SHR2 = 0x112, DPP_ROR1 = 0x121, DPP_ROR2 = 0x122;

struct EpiBf16 {
    static constexpr bool PERM = true, AFTER_DRAIN = false, MIDHOOK = false;
    bf16_t* O; int ldc; int split_cols; size_t split_stride; float scale0; int mid_t;
    __device__ __forceinline__ void mid(f32x4 (&)[2][2][4][2], const Unit&, int, int) const {}
    __device__ __forceinline__ void operator()(const f32x4 (&acc)[2][2][4][2], const Unit& u, int wr, int wc, int fr, int fq) const {
        const int row0 = u.pm * BM + wr * 64 + fr; int colt = u.pn * BM; bf16_t* base = O;
        float sc = 1.f; { const int t = colt / split_cols; base += (size_t)t * split_stride; colt -= t * split_cols; if (t == 0) sc = scale0; }
        const int col0 = colt + wc * 32 + 8 * fq;
#pragma unroll
        for (int ai = 0; ai < 2; ++ai)
#pragma unroll
            for (int m = 0; m < 4; ++m) { bf16_t* rowp = base + (size_t)(row0 + ai * HALF + m * 16) * ldc + col0;
#pragma unroll
                for (int bj = 0; bj < 2; ++bj) { f32x4 v0 = acc[ai][bj][m][0] * sc, v1 = acc[ai][bj][m][1] * sc;
                    u32x4 w; w.x = cvt_pk_bf16(v0[0], v0[1]); w.y = cvt_pk_bf16(v0[2], v0[3]); w.z = cvt_pk_bf16(v1[0], v1[1]); w.w = cvt_pk_bf16(v1[2], v1[3]);
                    *(u32x4*)(rowp + bj * HALF) = w; } }
    }
};

struct EpiX1 {
    static constexpr bool PERM = false, AFTER_DRAIN = false, MIDHOOK = true;
    const float* x; float* x1; bf16_t* x1b; float* ssq1; const float* ssqa; int mid_t;
    __device__ __forceinline__ void mid(f32x4 (&acc)[2][2][4][2], const Unit& u, int wr, int fr) const {
        asm volatile("" : "+v"(fr));
#pragma unroll
        for (int ai = 0; ai < 2; ++ai)
#pragma unroll
            for (int m = 0; m < 4; ++m) { const int row = u.pm * BM + ai * HALF + wr * 64 + m * 16 + fr;
                const f32x4 s0 = *(const f32x4*)(ssqa + (size_t)row * 8), s1 = *(const f32x4*)(ssqa + (size_t)row * 8 + 4);
                const float s = ((s0[0] + s0[1]) + (s0[2] + s0[3])) + ((s1[0] + s1[1]) + (s1[2] + s1[3]));
                float r = __builtin_amdgcn_rsqf(s * (1.0f / 512.0f) + RMS_EPS);
                asm volatile("" : "+v"(r) :: "memory");
#pragma unroll
                for (int bj = 0; bj < 2; ++bj)
#pragma unroll
                    for (int n = 0; n < 2; ++n) acc[ai][bj][m][n] = acc[ai][bj][m][n] * r; }
    }
    __device__ __forceinline__ void operator()(const f32x4 (&acc)[2][2][4][2], const Unit& u, int wr, int wc, int fr, int fq) const {
        asm volatile("" : "+v"(fr), "+v"(fq));
        const int row0 = u.pm * BM + wr * 64 + fr, col0 = u.pn * BM + wc * 32 + 4 * fq;
#pragma unroll
        for (int ai = 0; ai < 2; ++ai)
#pragma unroll
            for (int m = 0; m < 4; ++m) { const int row = row0 + ai * HALF + m * 16; float ss = 0.f;
#pragma unroll
                for (int bj = 0; bj < 2; ++bj)
#pragma unroll
                    for (int n = 0; n < 2; ++n) { const size_t off = (size_t)row * DMODEL + col0 + bj * HALF + n * 16;
                        const f32x4 v = *(const f32x4*)(x + off) + acc[ai][bj][m][n];
                        *(f32x4*)(x1 + off) = v;
                        u32x2 w; w.x = cvt_pk_bf16(v[0], v[1]); w.y = cvt_pk_bf16(v[2], v[3]); *(u32x2*)(x1b + off) = w;
                        ss += (v[0] * v[0] + v[1] * v[1]) + (v[2] * v[2] + v[3] * v[3]); }
                ss += __shfl_xor(ss, 16); ss += __shfl_xor(ss, 32);
                if (fq == 0) ssq1[(size_t)row * 16 + u.pn * 4 + wc] = ss;
                asm volatile("" ::: "memory"); }
    }
};

struct EpiDown {
    static constexpr bool PERM = false, AFTER_DRAIN = false, MIDHOOK = false;
    float* xio; float* ssq2; int mid_t;
    __device__ __forceinline__ void mid(f32x4 (&)[2][2][4][2], const Unit&, int, int) const {}
    __device__ __forceinline__ void operator()(const f32x4 (&acc)[2][2][4][2], const Unit& u, int wr, int wc, int fr, int fq) const {
        asm volatile("" : "+v"(fr), "+v"(fq));
        const int row0 = u.pm * BM + wr * 64 + fr, col0 = u.pn * BM + wc * 32 + 4 * fq;
#pragma unroll
        for (int ai = 0; ai < 2; ++ai)
#pragma unroll
            for (int m = 0; m < 4; ++m) { const int row = row0 + ai * HALF + m * 16; float ss = 0.f;
#pragma unroll
                for (int bj = 0; bj < 2; ++bj)
#pragma unroll
                    for (int n = 0; n < 2; ++n) { const size_t off = (size_t)row * DMODEL + col0 + bj * HALF + n * 16;
                        const f32x4 v = *(const f32x4*)(xio + off) + acc[ai][bj][m][n];
                        *(f32x4*)(xio + off) = v;
                        ss += (v[0] * v[0] + v[1] * v[1]) + (v[2] * v[2] + v[3] * v[3]); }
                ss += __shfl_xor(ss, 16); ss += __shfl_xor(ss, 32);
                if (fq == 0) ssq2[(size_t)row * 16 + u.pn * 4 + wc] = ss;
                asm volatile("" ::: "memory"); }
    }
};

struct EpiUp {
    static constexpr bool PERM = true, AFTER_DRAIN = false, MIDHOOK = false;
    bf16_t* act; const float* ssq1; const float* wconv; float* hf; float* hl; int mid_t;
    __device__ __forceinline__ void mid(f32x4 (&)[2][2][4][2], const Unit&, int, int) const {}
    __device__ __forceinline__ void operator()(f32x4 (&acc)[2][2][4][2], const Unit& u, int wr, int wc, int fr, int fq) const {
        asm volatile("" : "+v"(fr), "+v"(fq));
        const int ch0 = u.pn * 128 + wc * 32 + 8 * fq;
#pragma unroll
        for (int ai = 0; ai < 2; ++ai) {
#pragma unroll
            for (int m = 0; m < 4; ++m) { const int row = u.pm * BM + ai * HALF + wr * 64 + m * 16 + fr; const f32x4* sp = (const f32x4*)(ssq1 + (size_t)row * 16);
                const f32x4 a = sp[0], b = sp[1], c = sp[2], d = sp[3];
                const float s = (((a[0] + a[1]) + (a[2] + a[3])) + ((b[0] + b[1]) + (b[2] + b[3]))) + (((c[0] + c[1]) + (c[2] + c[3])) + ((d[0] + d[1]) + (d[2] + d[3])));
                float r = __builtin_amdgcn_rsqf(s * (1.0f / 1024.0f) + RMS_EPS);
                asm volatile("" : "+v"(r) :: "memory");
#pragma unroll
                for (int bj = 0; bj < 2; ++bj)
#pragma unroll
                    for (int n = 0; n < 2; ++n) acc[ai][bj][m][n] = acc[ai][bj][m][n] * r; }
            __builtin_amdgcn_sched_barrier(0);
            const int blk = u.pm * 4 + ai * 2 + wr;
            if (fr < 2) {
#pragma unroll
                for (int bj = 0; bj < 2; ++bj)
#pragma unroll
                    for (int n = 0; n < 2; ++n) *(f32x4*)(hf + ((size_t)(blk * 2 + fr) * 2 + bj) * DFF + ch0 + 4 * n) = acc[ai][bj][0][n]; }
            if (fr >= 14) {
#pragma unroll
                for (int bj = 0; bj < 2; ++bj)
#pragma unroll
                    for (int n = 0; n < 2; ++n) *(f32x4*)(hl + ((size_t)(blk * 2 + (fr - 14)) * 2 + bj) * DFF + ch0 + 4 * n) = acc[ai][bj][3][n]; }
            __builtin_amdgcn_sched_barrier(0);
#pragma unroll
            for (int bj = 0; bj < 2; ++bj)
#pragma unroll
                for (int n = 0; n < 2; ++n) {
                    const f32x4 w0 = *(const f32x4*)(wconv + bj * DFF + ch0 + 4 * n), w1 = *(const f32x4*)(wconv + (size_t)(2 * DFF) + bj * DFF + ch0 + 4 * n), w2 = *(const f32x4*)(wconv + (size_t)(4 * DFF) + bj * DFF + ch0 + 4 * n);
#pragma unroll
                    for (int m = 3; m >= 0; --m) {
                        if (m > 0) asm volatile("" : "+v"(acc[ai][bj][m][n]), "+v"(acc[ai][bj][m - 1][n])); else asm volatile("" : "+v"(acc[ai][bj][m][n]));
                        f32x4 res;
#pragma unroll
                        for (int j = 0; j < 4; ++j) {
                            const float cur = acc[ai][bj][m][n][j];
                            float o1 = 0.f, o2 = 0.f;
                            if (m > 0) { const float prv = acc[ai][bj][m - 1][n][j]; o1 = dpp_mov<DPP_ROR1>(0.f, prv); o2 = dpp_mov<DPP_ROR2>(0.f, prv); }
                            const float s1 = dpp_mov<DPP_SHR1>(o1, cur), s2 = dpp_mov<DPP_SHR2>(o2, cur);
                            res[j] = w2[j] * cur + w1[j] * s1 + w0[j] * s2; }
                        acc[ai][bj][m][n] = res; asm volatile("" : "+v"(acc[ai][bj][m][n])); }
                    asm volatile("" ::: "memory"); __builtin_amdgcn_sched_barrier(0);
                }
#pragma unroll
            for (int m = 0; m < 4; ++m) {
                float o[8];
#pragma unroll
                for (int n = 0; n < 2; ++n)
#pragma unroll
                    for (int j = 0; j < 4; ++j) { const float a = acc[ai][0][m][n][j], g = acc[ai][1][m][n][j]; const float e = __builtin_amdgcn_exp2f(-g * LOG2E); o[4 * n + j] = a * g * __builtin_amdgcn_rcpf(1.0f + e); }
                u32x4 pk; pk.x = cvt_pk_bf16(o[0], o[1]); pk.y = cvt_pk_bf16(o[2], o[3]); pk.z = cvt_pk_bf16(o[4], o[5]); pk.w = cvt_pk_bf16(o[6], o[7]);
                const int row = u.pm * BM + ai * HALF + wr * 64 + m * 16 + fr;
                *(u32x4*)(act + (size_t)row * DFF + ch0) = pk; __builtin_amdgcn_sched_barrier(0); }
        }
    }
};

template <class Epi, class Sched, bool ALIGN_EPI = false, bool SP2 = false>
__device__ __forceinline__ void gemm_phase(PG8_LAS unsigned char* lds, const Gemm g, const Sched& S, const Epi& E) {
    const int tid = threadIdx.x, wid = __builtin_amdgcn_readfirstlane(tid >> 6), lane = tid & 63, wr = wid >> 2, wc = wid & 3, fr = lane & 15, fq = lane >> 4;
    const int K = g.K, nt = K / BK;
    unsigned voffA[2], voffB[2];
#pragma unroll
    for (int i = 0; i < 2; ++i) { int R, C; stage_rc(tid * 16 + i * 8192, R, C); const int Rb = Epi::PERM ? ((R & ~31) + perm32(R & 31)) : R;
        voffA[i] = (unsigned)(R * K + C) * 2u; voffB[i] = (unsigned)(Rb * K + C) * 2u; }
    const size_t kstep = (size_t)(BK * 2);
    const size_t hstep = (size_t)HALF * K * 2;
    const size_t tstep = 2 * hstep;
    const unsigned ldsw = (unsigned)wid * 1024u;
    const int aoff = lds_byte(wr * 64 + fr, fq * 8), boff = lds_byte(wc * 32 + fr, fq * 8);
#define PG8_SA(b, h) (((b) * 2 + (h)) * HTB)
#define PG8_SB(b, h) ((4 + (b) * 2 + (h)) * HTB)
#define PG8_STAGE(bufoff, gbase, voff) do { _Pragma("unroll") for (int _i = 0; _i < 2; ++_i) \
        __builtin_amdgcn_global_load_lds((const unsigned*)((const char*)(gbase) + (voff)[_i]), (PG8_LAS unsigned*)(lds + (bufoff) + ldsw + _i * 8192), 16, 0, 0); } while (0)
#define PG8_LDA(dst, b, h) do { _Pragma("unroll") for (int m = 0; m < 4; ++m) _Pragma("unroll") for (int k = 0; k < 2; ++k) dst[m][k] = *(const PG8_LAS bf16x8*)(lds + PG8_SA(b, h) + aoff + m * 2048 + k * 1024); } while (0)
#define PG8_LDB(dst, b, h) do { _Pragma("unroll") for (int n = 0; n < 2; ++n) _Pragma("unroll") for (int k = 0; k < 2; ++k) dst[n][k] = *(const PG8_LAS bf16x8*)(lds + PG8_SB(b, h) + boff + n * 2048 + k * 1024); } while (0)
#define PG8_MMA(ai, bj, At, Bt) do { __builtin_amdgcn_s_setprio(1); _Pragma("unroll") for (int m = 0; m < 4; ++m) _Pragma("unroll") for (int n = 0; n < 2; ++n) _Pragma("unroll") for (int k = 0; k < 2; ++k) \
        acc[ai][bj][m][n] = __builtin_amdgcn_mfma_f32_16x16x32_bf16(Bt[n][k], At[m][k], acc[ai][bj][m][n], 0, 0, 0); __builtin_amdgcn_s_setprio(0); } while (0)
#define PG8_WAIT_V(n) asm volatile("s_waitcnt vmcnt(" #n ")" ::: "memory")
#define PG8_WAIT_L(n) asm volatile("s_waitcnt lgkmcnt(" #n ")" ::: "memory")
#define PG8_BAR __builtin_amdgcn_s_barrier()
#define PG8_SCHED __builtin_amdgcn_sched_barrier(0)
    Unit cur, nxt; int ui = 0;
    if (!S.next(0, cur)) return;
    f32x4 acc[2][2][4][2];
#pragma unroll
    for (int a = 0; a < 2; ++a)
#pragma unroll
        for (int b = 0; b < 2; ++b)
#pragma unroll
            for (int m = 0; m < 4; ++m)
#pragma unroll
                for (int n = 0; n < 2; ++n) acc[a][b][m][n] = (f32x4){0.f, 0.f, 0.f, 0.f};
    bf16x8 At[4][2], B0[2][2], B1[2][2];
    const char* cA = (const char*)g.A + (size_t)cur.pm * tstep; const char* cB = (const char*)g.Bt + (size_t)cur.pn * tstep;
    S.a_ready(cur);
    if constexpr (SP2) {
        PG8_STAGE(PG8_SB(0, 0), cB, voffB); PG8_STAGE(PG8_SB(0, 1), cB + hstep, voffB); PG8_STAGE(PG8_SA(0, 0), cA, voffA); PG8_STAGE(PG8_SA(0, 1), cA + hstep, voffA);
        if (wr == 1) PG8_BAR;
        PG8_WAIT_V(2); PG8_BAR;
        PG8_STAGE(PG8_SB(1, 0), cB + kstep, voffB); PG8_STAGE(PG8_SA(1, 0), cA + kstep, voffA); PG8_STAGE(PG8_SB(1, 1), cB + hstep + kstep, voffB);
        PG8_WAIT_V(6); PG8_BAR;
    } else {
        PG8_STAGE(PG8_SB(0, 0), cB, voffB); PG8_STAGE(PG8_SA(0, 0), cA, voffA); PG8_STAGE(PG8_SB(0, 1), cB + hstep, voffB); PG8_STAGE(PG8_SA(0, 1), cA + hstep, voffA);
        if (wr == 1) PG8_BAR;
        PG8_WAIT_V(4); PG8_BAR;
        PG8_STAGE(PG8_SB(1, 0), cB + kstep, voffB); PG8_STAGE(PG8_SA(1, 0), cA + kstep, voffA); PG8_STAGE(PG8_SB(1, 1), cB + hstep + kstep, voffB);
        PG8_WAIT_V(6); PG8_BAR;
    }
    for (;;) {
        const bool has_next = S.next(ui + 1, nxt);
        const char* nA = has_next ? (const char*)g.A + (size_t)nxt.pm * tstep : cA; const char* nB = has_next ? (const char*)g.Bt + (size_t)nxt.pn * tstep : cB;
        for (int t = 0; t < nt; t += 2) {
            if constexpr (Epi::MIDHOOK) { if (t == E.mid_t) E.mid(acc, cur, wr, fr); }
            const bool last = (t == nt - 2);
            const char* a1 = cA + (size_t)(t + 1) * kstep;
            const char* a2 = last ? nA : cA + (size_t)(t + 2) * kstep; const char* b2 = last ? nB : cB + (size_t)(t + 2) * kstep;
            const char* a3 = a2 + kstep; const char* b3 = b2 + kstep;
            if (last && has_next) S.a_ready(nxt);
            if constexpr (SP2) {
            PG8_LDB(B0, 0, 0); PG8_LDB(B1, 0, 1); PG8_SCHED; PG8_LDA(At, 0, 0); PG8_STAGE(PG8_SA(1, 1), a1 + hstep, voffA);
            PG8_WAIT_V(8); PG8_WAIT_L(0); PG8_BAR; PG8_MMA(0, 0, At, B0); PG8_MMA(0, 1, At, B1); PG8_BAR; PG8_SCHED;
            PG8_LDA(At, 0, 1); PG8_STAGE(PG8_SB(0, 0), b2, voffB); PG8_STAGE(PG8_SB(0, 1), b2 + hstep, voffB); PG8_STAGE(PG8_SA(0, 0), a2, voffA);
            PG8_WAIT_V(8); PG8_WAIT_L(0); PG8_BAR; PG8_MMA(1, 0, At, B0); PG8_MMA(1, 1, At, B1); PG8_BAR; PG8_SCHED;
            PG8_LDB(B0, 1, 0); PG8_LDB(B1, 1, 1); PG8_SCHED; PG8_LDA(At, 1, 0); PG8_STAGE(PG8_SA(0, 1), a2 + hstep, voffA);
            PG8_WAIT_V(8); PG8_WAIT_L(0); PG8_BAR; PG8_MMA(0, 0, At, B0); PG8_MMA(0, 1, At, B1); PG8_BAR; PG8_SCHED;
            PG8_LDA(At, 1, 1); PG8_STAGE(PG8_SB(1, 0), b3, voffB); PG8_STAGE(PG8_SB(1, 1), b3 + hstep, voffB); PG8_STAGE(PG8_SA(1, 0), a3, voffA);
            PG8_WAIT_V(8); PG8_WAIT_L(0); PG8_BAR; PG8_MMA(1, 0, At, B0); PG8_MMA(1, 1, At, B1); PG8_BAR; PG8_SCHED;
            } else {
            PG8_LDB(B0, 0, 0); PG8_SCHED; PG8_LDA(At, 0, 0); PG8_STAGE(PG8_SA(1, 1), a1 + hstep, voffA);
            PG8_WAIT_L(8); PG8_BAR; PG8_WAIT_L(0); PG8_MMA(0, 0, At, B0); PG8_BAR; PG8_SCHED;
            PG8_LDB(B1, 0, 1); PG8_STAGE(PG8_SB(0, 0), b2, voffB);
            PG8_BAR; PG8_WAIT_L(0); PG8_MMA(0, 1, At, B1); PG8_BAR;
            PG8_LDA(At, 0, 1); PG8_STAGE(PG8_SA(0, 0), a2, voffA);
            PG8_BAR; PG8_WAIT_L(0); PG8_MMA(1, 0, At, B0); PG8_BAR; PG8_SCHED;
            PG8_STAGE(PG8_SB(0, 1), b2 + hstep, voffB);
            PG8_WAIT_V(6); PG8_BAR; PG8_MMA(1, 1, At, B1); PG8_BAR;
            PG8_LDB(B0, 1, 0); PG8_SCHED; PG8_LDA(At, 1, 0); PG8_STAGE(PG8_SA(0, 1), a2 + hstep, voffA);
            PG8_WAIT_L(8); PG8_BAR; PG8_WAIT_L(0); PG8_MMA(0, 0, At, B0); PG8_BAR; PG8_SCHED;
            PG8_LDB(B1, 1, 1); PG8_STAGE(PG8_SB(1, 0), b3, voffB);
            PG8_BAR; PG8_WAIT_L(0); PG8_MMA(0, 1, At, B1); PG8_BAR;
            PG8_LDA(At, 1, 1); PG8_STAGE(PG8_SA(1, 0), a3, voffA);
            PG8_BAR; PG8_WAIT_L(0); PG8_MMA(1, 0, At, B0); PG8_BAR; PG8_SCHED;
            PG8_STAGE(PG8_SB(1, 1), b3 + hstep, voffB);
            PG8_WAIT_V(6); PG8_BAR; PG8_MMA(1, 1, At, B1); PG8_BAR;
            }
        }
        if constexpr (ALIGN_EPI) { if (wr == 0) PG8_BAR; }
        if constexpr (!Epi::AFTER_DRAIN) { E(acc, cur, wr, wc, fr, fq); S.done(cur); }
        if (!has_next) break;
#pragma unroll
        for (int a = 0; a < 2; ++a)
#pragma unroll
            for (int b = 0; b < 2; ++b)
#pragma unroll
                for (int m = 0; m < 4; ++m)
#pragma unroll
                    for (int n = 0; n < 2; ++n) acc[a][b][m][n] = (f32x4){0.f, 0.f, 0.f, 0.f};
        cur = nxt; cA = nA; cB = nB; ++ui;
        if constexpr (ALIGN_EPI) { if (wr == 1) PG8_BAR; }
    }
    PG8_WAIT_V(0);
    if constexpr (!ALIGN_EPI) { if (wr == 0) PG8_BAR; }
    PG8_BAR;
    if constexpr (Epi::AFTER_DRAIN) { E.fused(acc, cur, wr, wc, fr, fq, lds, wid, lane); S.done(cur); }
#undef PG8_SA
#undef PG8_SB
#undef PG8_STAGE
#undef PG8_LDA
#undef PG8_LDB
#undef PG8_MMA
#undef PG8_WAIT_V
#undef PG8_WAIT_L
#undef PG8_BAR
#undef PG8_SCHED
}
}
#include <hip/hip_bf16.h>
#include <cmath>
namespace attn_body {
using bf16=__hip_bfloat16;
using bf16x8=__attribute__((ext_vector_type(8)))short;
using s16x4=__attribute__((ext_vector_type(4)))short;
using f32x16=__attribute__((ext_vector_type(16)))float;
using u32x4=__attribute__((ext_vector_type(4)))unsigned;
constexpr int BATCH=4,NHEAD=8,SEQ=8192,D=64,KVP=512,OP=1024;
constexpr int NW=8,QBLK=32,QB=QBLK*NW,KVBLK=64,NQB=SEQ/QB;
constexpr int ATTN_UNIT_ROWS=QB;
__device__ __forceinline__ int crow(int r,int hi){return (r&3)+8*(r>>2)+4*hi;}
#define SBAR() __builtin_amdgcn_sched_barrier(0)
__device__ __forceinline__ void cmask(f32x16&p0,f32x16&p1,int jb,int qrel,int hi){
  const float NEG=-INFINITY; int kb=64*jb+4*hi;
  #pragma unroll
  for(int r=0;r<16;++r){int kv=kb+(r&3)+8*(r>>2); if(kv>qrel)p0[r]=NEG; if(kv+32>qrel)p1[r]=NEG;}
}

constexpr int NSLOT=3, SLOTB=8192;
constexpr int LDS_K=0, LDS_V=NSLOT*SLOTB, LDS_WS=2*NSLOT*SLOTB, LDS_OST=LDS_WS+NW*64*4, LDS_FB=LDS_OST+NW*4096, LDS_BYTES=LDS_FB+SEQ*4;
constexpr float C2=0.125f*1.4426950408889634f;
__device__ __forceinline__ void glds16(const void*gsrc,unsigned lds_dst){unsigned keep;
  asm volatile("s_mov_b32 %0, m0\n\ts_mov_b32 m0, %2\n\ts_nop 0\n\tglobal_load_lds_dwordx4 %1, off\n\ts_mov_b32 m0, %0":"=&s"(keep):"v"(gsrc),"s"(lds_dst):"memory");}
__device__ __forceinline__ float max3f(float a,float b,float c){float r;asm("v_max3_f32 %0, %1, %2, %3":"=v"(r):"v"(a),"v"(b),"v"(c));return r;}
__device__ __forceinline__ float max2f(float a,float b){float r;asm("v_max_f32_e32 %0, %1, %2":"=v"(r):"v"(a),"v"(b));return r;}
__device__ __forceinline__ float fadd_s(float a,float b){float r;asm("v_add_f32_e32 %0, %1, %2":"=v"(r):"v"(a),"v"(b));return r;}
__device__ __forceinline__ float fsub_s(float a,float b){float r;asm("v_sub_f32_e32 %0, %1, %2":"=v"(r):"v"(a),"v"(b));return r;}
typedef float f32x2_t __attribute__((ext_vector_type(2))); typedef __bf16 bf16x2_t __attribute__((ext_vector_type(2)));
__device__ __forceinline__ unsigned cvtpk_s(float lo,float hi){f32x2_t v={lo,hi};bf16x2_t b=__builtin_convertvector(v,bf16x2_t);return __builtin_bit_cast(unsigned,b);}
#define WAIT_BAR(N) asm volatile("s_waitcnt vmcnt(" #N ") lgkmcnt(0)\n\ts_barrier":::"memory")

__device__ __forceinline__ void qkt(f32x16&p0,f32x16&p1,const char*Kslot,const bf16x8*qr,int r32,int hi){
  const char*kb=Kslot+hi*1024+r32*16;
  #pragma unroll
  for(int d0=0;d0<4;++d0){
    const bf16x8 b0=*reinterpret_cast<const bf16x8*>(kb+d0*2048);
    const bf16x8 b1=*reinterpret_cast<const bf16x8*>(kb+d0*2048+512);
    p0=__builtin_amdgcn_mfma_f32_32x32x16_bf16(b0,qr[d0],p0,0,0,0);p1=__builtin_amdgcn_mfma_f32_32x32x16_bf16(b1,qr[d0],p1,0,0,0);}
}
typedef __attribute__((address_space(3))) const char* lds_cptr;
typedef __attribute__((address_space(3))) char* lds_cptr_nc;
typedef float f32x4_t __attribute__((ext_vector_type(4)));
typedef short v4i16_t __attribute__((ext_vector_type(4)));
__device__ __forceinline__ void kload8(bf16x8*kf,lds_cptr kp){
  kf[0]=*(const __attribute__((address_space(3))) bf16x8*)(kp);      kf[1]=*(const __attribute__((address_space(3))) bf16x8*)(kp+512);
  kf[2]=*(const __attribute__((address_space(3))) bf16x8*)(kp+2048); kf[3]=*(const __attribute__((address_space(3))) bf16x8*)(kp+2560);
  kf[4]=*(const __attribute__((address_space(3))) bf16x8*)(kp+4096); kf[5]=*(const __attribute__((address_space(3))) bf16x8*)(kp+4608);
  kf[6]=*(const __attribute__((address_space(3))) bf16x8*)(kp+6144); kf[7]=*(const __attribute__((address_space(3))) bf16x8*)(kp+6656);
}
__device__ __forceinline__ void kload2(bf16x8*kf,lds_cptr kp,int j){ kf[2*j]=*(const __attribute__((address_space(3))) bf16x8*)(kp+j*2048); kf[2*j+1]=*(const __attribute__((address_space(3))) bf16x8*)(kp+j*2048+512); }
__device__ __forceinline__ s16x4 vtr(lds_cptr p){ return __builtin_bit_cast(s16x4,__builtin_amdgcn_ds_read_tr16_b64_v4i16((__attribute__((address_space(3))) v4i16_t*)p)); }
__device__ __forceinline__ float rowmax(const f32x16&p0,const f32x16&p1){
  float a=max3f(p0[0],p0[1],p1[0]),b=max3f(p0[2],p0[3],p1[1]);a=max3f(a,p1[2],p1[3]);
  #pragma unroll
  for(int r=4;r<16;r+=4){a=max3f(a,p0[r],p0[r+1]);b=max3f(b,p0[r+2],p0[r+3]);a=max3f(a,p1[r],p1[r+1]);b=max3f(b,p1[r+2],p1[r+3]);}
  const float m=max2f(a,b);
  auto rr=__builtin_amdgcn_permlane32_swap(__float_as_uint(m),__float_as_uint(m),false,false);
  return max2f(__uint_as_float(rr[0]),__uint_as_float(rr[1]));
}
__device__ __forceinline__ void pv(f32x16*o,int vb,bf16x8 pa0,bf16x8 pa1,bf16x8 pa2,bf16x8 pa3){
  #pragma unroll
  for(int d0=0;d0<2;++d0){s16x4 lo[4],hi[4];
    #pragma unroll
    for(int ks=0;ks<4;++ks){
      asm volatile("ds_read_b64_tr_b16 %0,%1 offset:%c2":"=&v"(lo[ks]):"v"(vb),"i"(d0*4096+ks*1024):"memory");
      asm volatile("ds_read_b64_tr_b16 %0,%1 offset:%c2":"=&v"(hi[ks]):"v"(vb),"i"(d0*4096+ks*1024+512):"memory");}
    asm volatile("s_waitcnt lgkmcnt(0)":::"memory");SBAR();
    #define PK(k) (bf16x8){lo[k][0],lo[k][1],lo[k][2],lo[k][3],hi[k][0],hi[k][1],hi[k][2],hi[k][3]}
    o[d0]=__builtin_amdgcn_mfma_f32_32x32x16_bf16(pa0,PK(0),o[d0],0,0,0);
    o[d0]=__builtin_amdgcn_mfma_f32_32x32x16_bf16(pa1,PK(1),o[d0],0,0,0);
    o[d0]=__builtin_amdgcn_mfma_f32_32x32x16_bf16(pa2,PK(2),o[d0],0,0,0);
    o[d0]=__builtin_amdgcn_mfma_f32_32x32x16_bf16(pa3,PK(3),o[d0],0,0,0);
    #undef PK
  }
}

#ifndef ATTN_STORE16
#define ATTN_STORE16(p,v) (*(u32x4*)(p)=(v))
#endif
template<int THRL> __device__ __forceinline__ void attn_unit(int b,int h,int qb,const bf16*Q,const bf16*__restrict__ K,const bf16*__restrict__ V,const float*__restrict__ FB,bf16*O,float*SSQ,char*shm){
  const int tid=threadIdx.x,lane=tid&63,r32=lane&31,hi=lane>>5; const int wid=__builtin_amdgcn_readfirstlane(tid>>6);
  const long rowbase=(long)b*SEQ; const int q0=qb*QB;
  const bf16*Qw=Q+(rowbase+q0+wid*QBLK)*KVP+h*D;
  const bf16*Kh=K+rowbase*KVP+h*D,*Vh=V+rowbase*KVP+h*D;
  const unsigned lds0=(unsigned)(uintptr_t)shm;
  float*wsf=(float*)(shm+LDS_WS)+wid*64;
  const bf16*ksrc=Kh+(long)lane*KVP+wid*8;
  const bf16*vsrc=Vh+(long)(16*(wid&3)+(lane>>2))*KVP+(wid>>2)*32+(lane&3)*8;
  const unsigned kdst=lds0+LDS_K+wid*1024, vdst=lds0+LDS_V+wid*1024;
  #define DMA_K(t,slot) glds16(ksrc+(long)(t)*KVBLK*KVP,(unsigned)__builtin_amdgcn_readfirstlane(kdst+(slot)))
  #define DMA_V(t,slot) glds16(vsrc+(long)(t)*KVBLK*KVP,(unsigned)__builtin_amdgcn_readfirstlane(vdst+(slot)))
  const int vb0=(int)(lds0+LDS_V)+((lane>>4)&1)*32+(lane&3)*8+(4*hi+((lane&15)>>2))*64;
  const char*Kbase=shm+LDS_K; bf16x8 kf[8];
  const lds_cptr shm3=(lds_cptr)shm; const lds_cptr kp0=shm3+LDS_K+hi*1024+r32*16; const lds_cptr vp0=shm3+LDS_V+((lane>>4)&1)*32+(lane&3)*8+(4*hi+((lane&15)>>2))*64;
  const int NT=(q0+QB)/KVBLK;
  { const float*FBg=FB+(long)(b*NHEAD+h)*SEQ; typedef __attribute__((address_space(3))) f32x4_t* lds_f4p; const int nfb=q0+QB;
    for(int i=tid*4;i<nfb;i+=NW*64*4){ const f32x4_t v=*(const f32x4_t*)(FBg+i); *(lds_f4p)((lds_cptr_nc)shm+LDS_FB+i*4)=v; } }
  const lds_cptr fbp0=(lds_cptr)shm+LDS_FB+hi*16;
  DMA_K(0,0);DMA_V(0,0);DMA_K(1,SLOTB);
  bf16x8 qr[4];
  #pragma unroll
  for(int d0=0;d0<4;++d0)qr[d0]=*reinterpret_cast<const bf16x8*>(&Qw[(long)r32*KVP+d0*16+hi*8]);
  float mhat=0.f,l_reg=0.f;f32x16 o[2];o[0]=f32x16{};o[1]=f32x16{};
  #define FBC(C0,C1,t) do{ const lds_cptr fp_=fbp0+(t)*256; _Pragma("unroll") for(int g_=0;g_<4;++g_){ \
      const f32x4_t a_=*(const __attribute__((address_space(3))) f32x4_t*)(fp_+g_*32), b_=*(const __attribute__((address_space(3))) f32x4_t*)(fp_+128+g_*32); \
      _Pragma("unroll") for(int j_=0;j_<4;++j_){ C0[4*g_+j_]=a_[j_]-mhat; C1[4*g_+j_]=b_[j_]-mhat; } } }while(0)
  const int qrel=wid*QBLK+r32;
  #define CMASK(P0,P1,t) do{int jb_=(t)-(NT-4); if(jb_>=0)cmask(P0,P1,jb_,qrel,hi);}while(0)
  bool resc=false;
  #define START(P0,P1) do{ const float rm=rowmax(P0,P1); resc=false; \
    { const float dl=rm; mhat=fadd_s(mhat,dl); \
      _Pragma("unroll") for(int r=0;r<16;++r){P0[r]=fsub_s(P0[r],dl);P1[r]=fsub_s(P1[r],dl);} } \
    _Pragma("unroll") for(int r=0;r<16;++r)P0[r]=__builtin_amdgcn_exp2f(P0[r]); }while(0)
  #define RESC() do{ if(resc){ asm volatile("s_waitcnt lgkmcnt(0)":::"memory"); \
      _Pragma("unroll") for(int d_=0;d_<2;++d_) _Pragma("unroll") for(int r=0;r<16;++r)o[d_][r]*=wsf[crow(r,hi)]; } }while(0)
  f32x16 pA0,pA1,pB0,pB1;
  int sl_prev=0,sl_cur=0,sl_next=SLOTB;
  #define ROT() do{sl_prev=sl_cur;sl_cur=sl_next;sl_next=(sl_next==(NSLOT-1)*SLOTB)?0:sl_next+SLOTB;}while(0)
  DMA_K(2,2*SLOTB);
  WAIT_BAR(3);
  FBC(pA0,pA1,0);
  qkt(pA0,pA1,Kbase,qr,r32,hi);asm volatile("s_nop 15\n\ts_nop 7":"+v"(pA0),"+v"(pA1));CMASK(pA0,pA1,0);
  START(pA0,pA1);
  _Pragma("unroll") for(int r=0;r<16;++r)pA1[r]=__builtin_amdgcn_exp2f(pA1[r]);
  FBC(pB0,pB1,1);
  WAIT_BAR(0);
  DMA_K(3,0);DMA_V(1,SLOTB);
  ROT();
  kload8(kf,kp0+sl_cur);
  WAIT_BAR(2);
  s16x4 vlo[8],vhi[8]; u32x4 pw0,pw1,pw2,pw3;
  #define PKW(P,B) cvtpk_s(P[B],P[B+1])
  #define PAF(k) __builtin_bit_cast(bf16x8,pw##k)
  #define VFR(i) (bf16x8){vlo[i][0],vlo[i][1],vlo[i][2],vlo[i][3],vhi[i][0],vhi[i][1],vhi[i][2],vhi[i][3]}
  #define PIN(x) asm volatile("":"+v"(x))
  #define MX3(a,b,c) __builtin_fmaxf(__builtin_fmaxf((a),(b)),(c))
  #define GAPA(MF,A0,A1,A2,A3,W0,W1,PW) do{ MF; sacc+=A0; sacc+=A1; sacc+=A2; sacc+=A3; PIN(sacc); W0; W1; PIN(PW); SBAR(); }while(0)
  #define EX(v) __builtin_amdgcn_exp2f(v)
  #define GAPB(MF,X,B) do{ MF; X[B]=EX(X[B]); X[B+1]=EX(X[B+1]); X[B+2]=EX(X[B+2]); X[B+3]=EX(X[B+3]); PIN(X); SBAR(); }while(0)
  #define VRD(i) do{ vlo[i]=vtr(vp_+(((i)>>2)*4096+((i)&3)*1024)); vhi[i]=vtr(vp_+(((i)>>2)*4096+((i)&3)*1024+512)); }while(0)
  #define KRD(G,j) do{ if(G){ kload2(kf,kp0+sl_next,j); SBAR(); } }while(0)
  #define STEP(C0,C1,P0,P1,t,GK,GV,GL,GN) do{ SBAR(); \
    const lds_cptr vp_=vp0+sl_prev; \
    VRD(0); SBAR(); float sacc=(P0[0]+P0[1]); \
    GAPA(C0=__builtin_amdgcn_mfma_f32_32x32x16_bf16(kf[0],qr[0],C0,0,0,0), P0[2],P0[3],P0[4],P0[5],     pw0[0]=PKW(P0,0), pw0[1]=PKW(P0,2), pw0); \
    VRD(4); SBAR(); GAPA(C1=__builtin_amdgcn_mfma_f32_32x32x16_bf16(kf[1],qr[0],C1,0,0,0), P0[6],P0[7],P0[8],P0[9],     pw0[2]=PKW(P0,4), pw0[3]=PKW(P0,6), pw0); \
    VRD(1); SBAR(); GAPA(C0=__builtin_amdgcn_mfma_f32_32x32x16_bf16(kf[2],qr[1],C0,0,0,0),   P0[10],P0[11],P0[12],P0[13], pw1[0]=PKW(P0,8), pw1[1]=PKW(P0,10), pw1); \
    VRD(5); SBAR(); GAPA(C1=__builtin_amdgcn_mfma_f32_32x32x16_bf16(kf[3],qr[1],C1,0,0,0),   P0[14],P0[15],P1[0],P1[1],   pw1[2]=PKW(P0,12),pw1[3]=PKW(P0,14), pw1); \
    VRD(2); SBAR(); GAPA(C0=__builtin_amdgcn_mfma_f32_32x32x16_bf16(kf[4],qr[2],C0,0,0,0),   P1[2],P1[3],P1[4],P1[5],     pw2[0]=PKW(P1,0), pw2[1]=PKW(P1,2), pw2); \
    VRD(6); SBAR(); GAPA(C1=__builtin_amdgcn_mfma_f32_32x32x16_bf16(kf[5],qr[2],C1,0,0,0),   P1[6],P1[7],P1[8],P1[9],     pw2[2]=PKW(P1,4), pw2[3]=PKW(P1,6), pw2); \
    VRD(3); SBAR(); GAPA(C0=__builtin_amdgcn_mfma_f32_32x32x16_bf16(kf[6],qr[3],C0,0,0,0),   P1[10],P1[11],P1[12],P1[13], pw3[0]=PKW(P1,8), pw3[1]=PKW(P1,10), pw3); \
    VRD(7); SBAR(); GAPA(C1=__builtin_amdgcn_mfma_f32_32x32x16_bf16(kf[7],qr[3],C1,0,0,0),   P1[14],P1[15],0.f,0.f,       pw3[2]=PKW(P1,12),pw3[3]=PKW(P1,14), pw3); \
    l_reg+=sacc; \
    if(GK){DMA_K((t)+3,sl_cur);} if(GV){DMA_V((t)+1,sl_next);} \
    CMASK(C0,C1,t); \
    { float a=MX3(C0[0],C0[1],C1[0]),b=MX3(C0[2],C0[3],C1[1]); a=MX3(a,C1[2],C1[3]); \
      _Pragma("unroll") for(int r=4;r<16;r+=4){a=MX3(a,C0[r],C0[r+1]);b=MX3(b,C0[r+2],C0[r+3]);a=MX3(a,C1[r],C1[r+1]);b=MX3(b,C1[r+2],C1[r+3]);} \
      float rm=__builtin_fmaxf(a,b); { auto rr=__builtin_amdgcn_permlane32_swap(__float_as_uint(rm),__float_as_uint(rm),false,false); rm=__builtin_fmaxf(__uint_as_float(rr[0]),__uint_as_float(rr[1])); } \
      resc=false; \
      if(__builtin_expect(__any(rm>(float)THRL),0)){ const float dl=__builtin_fmaxf(rm,0.f); mhat+=dl; \
        _Pragma("unroll") for(int r=0;r<16;++r){C0[r]-=dl;C1[r]-=dl;} \
        const float f=__builtin_amdgcn_exp2f(-dl); l_reg*=f; if(hi==0)wsf[r32]=f; resc=true; } } \
    SBAR(); \
    GAPB(o[0]=__builtin_amdgcn_mfma_f32_32x32x16_bf16(PAF(0),VFR(0),o[0],0,0,0), C0,0); \
    GAPB(o[1]=__builtin_amdgcn_mfma_f32_32x32x16_bf16(PAF(0),VFR(4),o[1],0,0,0), C0,4); \
    KRD(GL,0); GAPB(o[0]=__builtin_amdgcn_mfma_f32_32x32x16_bf16(PAF(1),VFR(1),o[0],0,0,0), C0,8); \
    KRD(GL,1); GAPB(o[1]=__builtin_amdgcn_mfma_f32_32x32x16_bf16(PAF(1),VFR(5),o[1],0,0,0), C0,12); \
    KRD(GL,2); GAPB(o[0]=__builtin_amdgcn_mfma_f32_32x32x16_bf16(PAF(2),VFR(2),o[0],0,0,0), C1,0); \
    KRD(GL,3); GAPB(o[1]=__builtin_amdgcn_mfma_f32_32x32x16_bf16(PAF(2),VFR(6),o[1],0,0,0), C1,4); \
    GAPB(o[0]=__builtin_amdgcn_mfma_f32_32x32x16_bf16(PAF(3),VFR(3),o[0],0,0,0), C1,8); \
    GAPB(o[1]=__builtin_amdgcn_mfma_f32_32x32x16_bf16(PAF(3),VFR(7),o[1],0,0,0), C1,12); \
    if(GN){ FBC(P0,P1,(t)+1); } \
    }while(0)
  int t=1;
  #undef CMASK
  #define CMASK(P0,P1,t) do{}while(0)
  for(;t+5<NT;t+=2){
    STEP(pB0,pB1,pA0,pA1,t,true,true,true,true);     WAIT_BAR(2); RESC(); ROT();
    STEP(pA0,pA1,pB0,pB1,t+1,true,true,true,true);   WAIT_BAR(2); RESC(); ROT();
  }
  #undef CMASK
  #define CMASK(P0,P1,t) do{int jb_=(t)-(NT-4); if(jb_>=0)cmask(P0,P1,jb_,qrel,hi);}while(0)
  #define ENDW(tt) do{ if((tt)+3<NT){WAIT_BAR(2);} else if((tt)+2<NT){WAIT_BAR(1);} else {WAIT_BAR(0);} }while(0)
  for(;t+1<NT;t+=2){
    STEP(pB0,pB1,pA0,pA1,t,(t+3<NT),(t+1<NT),(t+1<NT),(t+1<NT));       ENDW(t);   RESC(); ROT();
    STEP(pA0,pA1,pB0,pB1,t+1,(t+4<NT),(t+2<NT),(t+2<NT),(t+2<NT));     ENDW(t+1); RESC(); ROT();
  }
  STEP(pB0,pB1,pA0,pA1,NT-1,false,false,false,false); RESC();
  { float sacc=pB0[0]+pB0[1]; _Pragma("unroll") for(int r=2;r<16;++r)sacc+=pB0[r]; _Pragma("unroll") for(int r=0;r<16;++r)sacc+=pB1[r]; l_reg+=sacc;
    pw0=(u32x4){PKW(pB0,0),PKW(pB0,2),PKW(pB0,4),PKW(pB0,6)};pw1=(u32x4){PKW(pB0,8),PKW(pB0,10),PKW(pB0,12),PKW(pB0,14)};pw2=(u32x4){PKW(pB1,0),PKW(pB1,2),PKW(pB1,4),PKW(pB1,6)};pw3=(u32x4){PKW(pB1,8),PKW(pB1,10),PKW(pB1,12),PKW(pB1,14)};
    SBAR(); pv(o,vb0+sl_cur,PAF(0),PAF(1),PAF(2),PAF(3)); }
  #undef PKW
  #undef PAF
  #undef VFR
  #undef PIN
  #undef MX3
  #undef GAPA
  #undef GAPB
  #undef EX
  #undef VRD
  #undef KRD
  #undef STEP
  #undef ENDW
  {auto rr=__builtin_amdgcn_permlane32_swap(__float_as_uint(l_reg),__float_as_uint(l_reg),false,false);l_reg=__uint_as_float(rr[0])+__uint_as_float(rr[1]);}
  if(hi==0)wsf[32+r32]=l_reg;asm volatile("s_waitcnt lgkmcnt(0)":::"memory");
  float rli[16];
  #pragma unroll
  for(int r=0;r<16;++r)rli[r]=__builtin_amdgcn_rcpf(wsf[32+crow(r,hi)]);
  bf16*Ow=O+(rowbase+q0+wid*QBLK)*OP+h*D; float*Sw=SSQ+(rowbase+q0+wid*QBLK)*NHEAD+h;
  { bf16*stg=(bf16*)(shm+LDS_OST)+wid*2048;
    #pragma unroll
    for(int r=0;r<16;++r){const int orow=crow(r,hi);
      #pragma unroll
      for(int d0=0;d0<2;++d0)stg[orow*64+d0*32+r32]=__float2bfloat16(o[d0][r]*rli[r]);}
    asm volatile("s_waitcnt lgkmcnt(0)":::"memory");
    #pragma unroll
    for(int i=0;i<4;++i){const int row=i*8+(lane>>3),ch=lane&7; const u32x4 v=*(const u32x4*)(stg+row*64+ch*8); ATTN_STORE16(Ow+(long)row*OP+ch*8,v);
      float ss=0.f;
      #pragma unroll
      for(int q=0;q<4;++q){const float lo_=__uint_as_float(v[q]<<16),hi_=__uint_as_float(v[q]&0xffff0000u); ss+=lo_*lo_+hi_*hi_;}
      ss+=__shfl_xor(ss,1);ss+=__shfl_xor(ss,2);ss+=__shfl_xor(ss,4); if(ch==0)Sw[(long)row*NHEAD]=ss;} }
  asm volatile("s_waitcnt lgkmcnt(0)\n\ts_barrier":::"memory");
  #undef DMA_K
  #undef DMA_V
  #undef CMASK
  #undef START
  #undef RESC
  #undef ROT
  #undef FBC
}
constexpr int ATTN_LDS_BYTES=LDS_BYTES;
struct AttnTensors { const bf16* Q; const bf16* K; const bf16* V; const float* FB; bf16* O; float* SSQ; };
struct AttnUnit { int bh; int qb; };
struct StaticOrder {
  int vcu;
  __device__ __forceinline__ explicit StaticOrder(int grid,int block):vcu((block%8)*(grid/8)+block/8){}
  __device__ __forceinline__ bool next(int i,AttnUnit&u)const{ if(i>=4)return false; const int s=vcu&7; u.bh=vcu>>3; u.qb=(i==0)?s:(i==1)?15-s:(i==2)?16+s:31-s; return true; }
  __device__ __forceinline__ void a_ready(const AttnUnit&)const{}
  __device__ __forceinline__ void done(const AttnUnit&)const{}
};
template<class Sched,int THRL=8> __device__ __forceinline__ void attn_phase(char*lds,const AttnTensors&T,const Sched&S){
  AttnUnit u;
  for(int i=0;S.next(i,u);++i){ S.a_ready(u); attn_unit<THRL>(u.bh/NHEAD,u.bh%NHEAD,u.qb,T.Q,T.K,T.V,T.FB,T.O,T.SSQ,lds); S.done(u); }
}
#undef SBAR
#undef WAIT_BAR
}
#define GAS __attribute__((address_space(1)))
#define LAS __attribute__((address_space(3)))
typedef unsigned short bf16;
typedef unsigned v4u __attribute__((ext_vector_type(4)));
typedef float f32x4 __attribute__((ext_vector_type(4)));
typedef short bf16x8 __attribute__((ext_vector_type(8)));
typedef GAS unsigned gu32;
typedef GAS unsigned long long gu64;
#define RLX_AGENT __ATOMIC_RELAXED, __HIP_MEMORY_SCOPE_AGENT
#define LDS_WAIT() asm volatile("s_waitcnt lgkmcnt(0)" ::: "memory")
#define VM_WAIT() asm volatile("s_waitcnt vmcnt(0)" ::: "memory")
__device__ __forceinline__ unsigned long long rt() { return __builtin_amdgcn_s_memrealtime(); }
__device__ __forceinline__ unsigned f2bf(float f) { unsigned u = __builtin_bit_cast(unsigned, f); return (u + 0x7fffu + ((u >> 16) & 1u)) >> 16; }
__device__ __forceinline__ unsigned pk2(float lo, float hi) { return f2bf(lo) | (f2bf(hi) << 16); }

#define XB_TMO      128
#define XB_XCNT(j)  (256  + 64 * (j))
#define XB_XSUB(j)  (1280 + 64 * (j))
#define XB_XGEN(j)  (2304 + 64 * (j))
#define XB_TOP      3328
#define XB_TOPGEN   3392
#define XCD_BAR_WORDS 3456
#define XB_SPIN_CAP (1u << 18)

__device__ __forceinline__ unsigned xb_ld(unsigned* p)              { return __hip_atomic_load(p, __ATOMIC_RELAXED, __HIP_MEMORY_SCOPE_AGENT); }
__device__ __forceinline__ unsigned xb_add(unsigned* p, unsigned v) { return __hip_atomic_fetch_add(p, v, __ATOMIC_RELAXED, __HIP_MEMORY_SCOPE_AGENT); }
__device__ __forceinline__ unsigned xb_xcc_id() { return (unsigned)__builtin_amdgcn_s_getreg((3 << 11) | 20) & 0xFu; }
#define XB_SPIN(cond, bar) do { unsigned _sp = 0; while (cond) { __builtin_amdgcn_s_sleep(1); \
    if ((++_sp & 255u) == 0u) { if (xb_ld(&(bar)[XB_TMO])) break; if (_sp > XB_SPIN_CAP) { atomicAdd(&(bar)[XB_TMO], 1u); break; } } } } while (0)

struct XcdBarrier {
    unsigned* bar; unsigned x;
    volatile LAS unsigned* st;
};

__device__ __forceinline__ XcdBarrier xcd_barrier_post(unsigned* bar, volatile LAS unsigned* st) {
    XcdBarrier b; b.bar = bar; b.x = xb_xcc_id(); b.st = st;
    if (threadIdx.x == 0) (void)xb_add(&bar[XB_XCNT(b.x)], 1u);
    return b;
}
__device__ __forceinline__ void xcd_barrier_complete(unsigned* bar, unsigned x, unsigned& nloc, unsigned& nx) {
    const unsigned G = gridDim.x * gridDim.y * gridDim.z;
    unsigned sum, cnt, mine, sp = 0u;
    for (;;) {
        sum = 0u; cnt = 0u; mine = 0u;
#pragma unroll
        for (unsigned j = 0; j < 16; ++j) { const unsigned c = xb_ld(&bar[XB_XCNT(j)]); sum += c; cnt += (c > 0u) ? 1u : 0u; mine = (j == x) ? c : mine; }
        if (sum == G) break;
        __builtin_amdgcn_s_sleep(1);
        if ((++sp & 255u) == 0u) { if (xb_ld(&bar[XB_TMO])) break; if (sp > XB_SPIN_CAP) { atomicAdd(&bar[XB_TMO], 1u); break; } }
    }
    nloc = mine > 0u ? mine : 1u; nx = cnt > 0u ? cnt : 1u;
}

__device__ __forceinline__ void xcd_barrier(const XcdBarrier& b) {
    asm volatile("s_waitcnt vmcnt(0)" ::: "memory");
    __syncthreads();
    if (threadIdx.x == 0) {
        unsigned* bar = b.bar;
        __builtin_amdgcn_s_waitcnt(0);
        unsigned nloc = b.st[0], nx = b.st[1];
        if (nloc == 0u) { xcd_barrier_complete(bar, b.x, nloc, nx); b.st[0] = nloc; b.st[1] = nx; }
        const unsigned old = xb_add(&bar[XB_XSUB(b.x)], 1u);
        const unsigned gen = old / nloc;
        if (old + 1u == (gen + 1u) * nloc) {
            __builtin_amdgcn_fence(__ATOMIC_RELEASE, "agent");
            asm volatile("s_waitcnt vmcnt(0)" ::: "memory");
            const unsigned og = xb_add(&bar[XB_TOP], 1u);
            const unsigned tg = og / nx;
            if (og + 1u == (tg + 1u) * nx) xb_add(&bar[XB_TOPGEN], 1u);
            else XB_SPIN(xb_ld(&bar[XB_TOPGEN]) == tg, bar);
            __builtin_amdgcn_fence(__ATOMIC_ACQUIRE, "agent");
            xb_add(&bar[XB_XGEN(b.x)], 1u);
            asm volatile("s_waitcnt vmcnt(0)" ::: "memory");
        } else {
            XB_SPIN(xb_ld(&bar[XB_XGEN(b.x)]) == gen, bar);
            __builtin_amdgcn_fence(__ATOMIC_ACQUIRE, "agent");
            asm volatile("s_waitcnt vmcnt(0)" ::: "memory");
        }
    }
    __syncthreads();
}

constexpr int NWAVES = 8;
constexpr int RING_OFF = 0, RING_BYTES = 131072;
constexpr int LDSCTL_OFF = RING_BYTES, MISC_OFF = LDSCTL_OFF + 320;
constexpr int LDS_BYTES = 147456;
static_assert(MISC_OFF + 128 <= LDS_BYTES && attn_body::ATTN_LDS_BYTES <= RING_BYTES, "LDS map");

struct Args { const float* in[13]; float* out; unsigned char* ws; int ph_lo, ph_hi, li, pad; };

struct Ctx {
    LAS unsigned char* lds;
    int tid, lane, wave, vcu, G;
    const float *x, *g_mix, *w_in, *b_f, *w_conv, *g_conv_out, *g_attn_out, *w_o, *g_ffn, *w_up, *w_ffn_conv, *w_down, *g_final;
    float* out; unsigned char* ws;
};

__device__ __forceinline__ float wave_sum(float v) {
#pragma unroll
    for (int o = 1; o < 64; o <<= 1) v += __shfl_xor(v, o);
    return v;
}
__device__ __forceinline__ float bflo(unsigned w) { return __uint_as_float(w << 16); }
__device__ __forceinline__ float bfhi(unsigned w) { return __uint_as_float(w & 0xffff0000u); }
__device__ __forceinline__ float log_sigmoid_f(float v) { return v < 0.f ? v - log1pf(expf(v)) : -log1pf(expf(-v)); }

__device__ __forceinline__ void p0_tr_item(const float* W, int ldw, int k0, int nsrc0, bf16* WT, int ldt, int ndst0, int kd0, const float* kscale, LAS float* scr, int lane) {
#pragma unroll 8
    for (int i = 0; i < 32; ++i) { const int kk = 2 * i + (lane >> 5); float v = W[(size_t)(k0 + kk) * ldw + nsrc0 + (lane & 31)]; if (kscale) v *= kscale[kk]; scr[kk * 33 + (lane & 31)] = v; }
    LDS_WAIT(); asm volatile("" ::: "memory");
    const int c = lane & 7;
#pragma unroll
    for (int j = 0; j < 4; ++j) { const int n = (lane >> 3) + 8 * j; const LAS float* s = scr + (8 * c) * 33 + n;
        v4u o; o.x = pk2(s[0 * 33], s[1 * 33]); o.y = pk2(s[2 * 33], s[3 * 33]); o.z = pk2(s[4 * 33], s[5 * 33]); o.w = pk2(s[6 * 33], s[7 * 33]);
        *(v4u*)(WT + (size_t)(ndst0 + n) * ldt + kd0 + 8 * c) = o; }
    LDS_WAIT(); asm volatile("" ::: "memory");
}

__device__ __forceinline__ void p0_prologue(Ctx& F) {
    LAS float* scr = (LAS float*)(F.lds + RING_OFF + F.wave * 16384);
    const int gw = F.vcu * NWAVES + F.wave, NGW = F.G * NWAVES;
    bf16* WIN = (bf16*)(F.ws + WS_WIN); bf16* WO = (bf16*)(F.ws + WS_WO); bf16* WUP = (bf16*)(F.ws + WS_WUP); bf16* WDN = (bf16*)(F.ws + WS_WDN);
    constexpr int I_IN = 16 * 96, I_O = 16 * 32, I_UP = 16 * 176, I_DN = 44 * 32, NITEMS = I_IN + I_O + I_UP + I_DN;
    for (int it = gw; it < NITEMS; it += NGW) {
        int r = it;
        if (r < I_IN) { const int kb = r / 96, nb = r % 96, a = nb >> 4, j0 = (nb & 15) * 32;
            const int sb = (a == 0) ? 1536 : (a == 1) ? 2048 : (a == 2) ? 2560 : (a == 3) ? 0 : (a == 4) ? 512 : 1024;
            p0_tr_item(F.w_in, IN_COLS, 64 * kb, sb + j0, WIN, DMODEL, 32 * nb, 64 * kb, nullptr, scr, F.lane); continue; }
        r -= I_IN;
        if (r < I_O) { const int kb = r / 32, nb = r % 32, k0 = 64 * kb;
            p0_tr_item(F.w_o, DMODEL, k0, 32 * nb, WO, DMODEL, 32 * nb, (k0 + 512) & 1023, k0 >= 512 ? F.g_attn_out + (k0 - 512) : nullptr, scr, F.lane); continue; }
        r -= I_O;
        if (r < I_UP) { const int kb = r / 176, nb = r % 176, nd = 32 * nb, pn = nd >> 8, bj = (nd >> 7) & 1, j0 = nd & 127;
            p0_tr_item(F.w_up, 2 * DFF, 64 * kb, bj * DFF + 128 * pn + j0, WUP, DMODEL, nd, 64 * kb, F.g_ffn + 64 * kb, scr, F.lane); continue; }
        r -= I_UP;
        { const int kb = r / 32, nb = r % 32; p0_tr_item(F.w_down, DMODEL, 64 * kb, 32 * nb, WDN, DFF, 32 * nb, 64 * kb, nullptr, scr, F.lane); }
    }
    __syncthreads();
    LAS float* wf = (LAS float*)(F.lds + RING_OFF);
    for (int i = F.tid; i < 8 * DMODEL; i += NWAVES * 64) { const int k = i >> 3, hh = i & 7; wf[hh * DMODEL + k] = F.w_in[(size_t)k * IN_COLS + NMAIN + hh]; }
    LDS_WAIT(); __syncthreads();
    bf16* H1 = (bf16*)(F.ws + WS_H1); float* LOGF = (float*)(F.ws + WS_LOGF);
    f32x4 gm[4];
#pragma unroll
    for (int j = 0; j < 4; ++j) gm[j] = ((const f32x4*)F.g_mix)[F.lane + 64 * j];
    const float bfv = F.b_f[F.lane & 7];
    for (int m = gw; m < TOK; m += NGW) {
        const f32x4* xr = (const f32x4*)(F.x + (size_t)m * DMODEL) + F.lane;
        f32x4 v[4]; float s = 0.f;
#pragma unroll
        for (int j = 0; j < 4; ++j) { v[j] = xr[64 * j]; s += (v[j].x * v[j].x + v[j].y * v[j].y) + (v[j].z * v[j].z + v[j].w * v[j].w); }
        const float rstd = 1.0f / sqrtf(wave_sum(s) * (1.0f / DMODEL) + RMS_EPS);
        unsigned long long* o8 = (unsigned long long*)(H1 + (size_t)m * DMODEL) + F.lane;
#pragma unroll
        for (int j = 0; j < 4; ++j) { v[j] = v[j] * rstd * gm[j]; o8[64 * j] = (unsigned long long)pk2(v[j].x, v[j].y) | ((unsigned long long)pk2(v[j].z, v[j].w) << 32); }
        float mine = 0.f;
#pragma unroll
        for (int hh = 0; hh < 8; ++hh) { float p = 0.f;
#pragma unroll
            for (int j = 0; j < 4; ++j) { const f32x4 w = *(const LAS f32x4*)(wf + hh * DMODEL + 256 * j + 4 * F.lane); p += (v[j].x * w.x + v[j].y * w.y) + (v[j].z * w.z + v[j].w * w.w); }
            p = wave_sum(p); if (F.lane == hh) mine = p; }
        if (F.lane < 8) LOGF[(size_t)((m / SEQ) * NHEADS + F.lane) * SEQ + (m % SEQ)] = log_sigmoid_f(mine + bfv);
    }
}

__device__ __forceinline__ void p1_scan(Ctx& F, int bh) {
    const float* lf = (const float*)(F.ws + WS_LOGF) + (size_t)bh * SEQ; float* fb = (float*)(F.ws + WS_FB) + (size_t)bh * SEQ;
    LAS float* wt = (LAS float*)(F.lds + RING_OFF);
    float e[16];
#pragma unroll
    for (int j = 0; j < 4; ++j) { const f32x4 t = ((const f32x4*)lf)[F.tid * 4 + j]; e[4 * j] = t.x; e[4 * j + 1] = t.y; e[4 * j + 2] = t.z; e[4 * j + 3] = t.w; }
#pragma unroll
    for (int j = 1; j < 16; ++j) e[j] += e[j - 1];
    float incl = e[15];
#pragma unroll
    for (int o = 1; o < 64; o <<= 1) { const float t = __shfl_up(incl, o); if (F.lane >= o) incl += t; }
    if (F.lane == 63) wt[F.wave] = incl;
    LDS_WAIT(); __syncthreads();
    float base = incl - e[15];
    for (int w = 0; w < F.wave; ++w) base += wt[w];
#pragma unroll
    for (int j = 0; j < 4; ++j) { f32x4 t; t.x = -LOG2E * (base + e[4 * j]); t.y = -LOG2E * (base + e[4 * j + 1]); t.z = -LOG2E * (base + e[4 * j + 2]); t.w = -LOG2E * (base + e[4 * j + 3]); ((f32x4*)fb)[F.tid * 4 + j] = t; }
    __syncthreads();
}

__device__ __forceinline__ void unpack8(const v4u w, float (&f)[8]) { f[0] = bflo(w.x); f[1] = bfhi(w.x); f[2] = bflo(w.y); f[3] = bfhi(w.y); f[4] = bflo(w.z); f[5] = bfhi(w.z); f[6] = bflo(w.w); f[7] = bfhi(w.w); }
__device__ __forceinline__ void p2_conv(Ctx& F) {
    const int gw = F.vcu * NWAVES + F.wave, NGW = F.G * NWAVES, c0 = 8 * F.lane;
    const bf16* GB = (const bf16*)(F.ws + WS_QKV + 3 * QKV_STRIDE); const bf16* GC = (const bf16*)(F.ws + WS_QKV + 4 * QKV_STRIDE); const bf16* XC = (const bf16*)(F.ws + WS_QKV + 5 * QKV_STRIDE);
    bf16* MIX = (bf16*)(F.ws + WS_MIX);
    float w0[8], w1[8], w2[8], gco[8];
#pragma unroll
    for (int j = 0; j < 8; ++j) { w0[j] = F.w_conv[c0 + j]; w1[j] = F.w_conv[CONV_CH + c0 + j]; w2[j] = F.w_conv[2 * CONV_CH + c0 + j]; gco[j] = F.g_conv_out[c0 + j]; }
    for (int run = gw; run < TOK / 16; run += NGW) {
        const int t0 = run * 16; float p2[8], p1[8];
        if ((t0 % SEQ) == 0) {
#pragma unroll
            for (int j = 0; j < 8; ++j) { p2[j] = 0.f; p1[j] = 0.f; }
        } else { float a[8], b[8];
            unpack8(*(const v4u*)(GC + (size_t)(t0 - 2) * CONV_CH + c0), a); unpack8(*(const v4u*)(XC + (size_t)(t0 - 2) * CONV_CH + c0), b);
#pragma unroll
            for (int j = 0; j < 8; ++j) p2[j] = a[j] * b[j];
            unpack8(*(const v4u*)(GC + (size_t)(t0 - 1) * CONV_CH + c0), a); unpack8(*(const v4u*)(XC + (size_t)(t0 - 1) * CONV_CH + c0), b);
#pragma unroll
            for (int j = 0; j < 8; ++j) p1[j] = a[j] * b[j]; }
        for (int i = 0; i < 16; ++i) { const size_t t = (size_t)(t0 + i); float gb[8], a[8], b[8], y[8]; float ss = 0.f;
            unpack8(*(const v4u*)(GB + t * CONV_CH + c0), gb); unpack8(*(const v4u*)(GC + t * CONV_CH + c0), a); unpack8(*(const v4u*)(XC + t * CONV_CH + c0), b);
#pragma unroll
            for (int j = 0; j < 8; ++j) { const float p = a[j] * b[j]; y[j] = gb[j] * (w0[j] * p2[j] + w1[j] * p1[j] + w2[j] * p); p2[j] = p1[j]; p1[j] = p; ss += y[j] * y[j]; }
            const float rstd = 1.0f / sqrtf(wave_sum(ss) * (1.0f / CONV_CH) + RMS_EPS);
            v4u o; o.x = pk2(y[0] * rstd * gco[0], y[1] * rstd * gco[1]); o.y = pk2(y[2] * rstd * gco[2], y[3] * rstd * gco[3]); o.z = pk2(y[4] * rstd * gco[4], y[5] * rstd * gco[5]); o.w = pk2(y[6] * rstd * gco[6], y[7] * rstd * gco[7]);
            *(v4u*)(MIX + t * DMODEL + CONV_CH + c0) = o; }
    }
}

__device__ __forceinline__ void p4_fixup(Ctx& F) {
    const float* HF = (const float*)(F.ws + WS_HF); const float* HL = (const float*)(F.ws + WS_HL); bf16* ACT = (bf16*)(F.ws + WS_ACT);
    constexpr int NCG = DFF / 8, NIT = 512 * 2 * NCG;
    for (int it = F.vcu * (NWAVES * 64) + F.tid; it < NIT; it += F.G * NWAVES * 64) {
        const int blk = it / (2 * NCG), rem = it % (2 * NCG), rr = rem / NCG, ch0 = 8 * (rem % NCG);
        const bool first = (blk % (SEQ / 64)) == 0;
        float u[2][8];
#pragma unroll
        for (int bj = 0; bj < 2; ++bj) {
            const float* c_ = HF + ((size_t)(blk * 2 + rr) * 2 + bj) * DFF + ch0;
            const float* p1_ = (rr == 1) ? HF + ((size_t)(blk * 2 + 0) * 2 + bj) * DFF + ch0 : HL + ((size_t)((blk - 1) * 2 + 1) * 2 + bj) * DFF + ch0;
            const float* p2_ = (rr == 1) ? HL + ((size_t)((blk - 1) * 2 + 1) * 2 + bj) * DFF + ch0 : HL + ((size_t)((blk - 1) * 2 + 0) * 2 + bj) * DFF + ch0;
            const bool z1 = first && rr == 0, z2 = first;
#pragma unroll
            for (int q = 0; q < 2; ++q) {
                const f32x4 cur = *(const f32x4*)(c_ + 4 * q);
                const f32x4 a1 = z1 ? (f32x4){0.f, 0.f, 0.f, 0.f} : *(const f32x4*)(p1_ + 4 * q);
                const f32x4 a2 = z2 ? (f32x4){0.f, 0.f, 0.f, 0.f} : *(const f32x4*)(p2_ + 4 * q);
                const f32x4 w0 = *(const f32x4*)(F.w_ffn_conv + bj * DFF + ch0 + 4 * q), w1 = *(const f32x4*)(F.w_ffn_conv + 2 * DFF + bj * DFF + ch0 + 4 * q), w2 = *(const f32x4*)(F.w_ffn_conv + 4 * DFF + bj * DFF + ch0 + 4 * q);
                const f32x4 r = w2 * cur + w1 * a1 + w0 * a2;
                u[bj][4 * q] = r.x; u[bj][4 * q + 1] = r.y; u[bj][4 * q + 2] = r.z; u[bj][4 * q + 3] = r.w; }
        }
        float o[8];
#pragma unroll
        for (int j = 0; j < 8; ++j) { const float a = u[0][j], g = u[1][j]; o[j] = a * g * __builtin_amdgcn_rcpf(1.0f + __builtin_amdgcn_exp2f(-g * LOG2E)); }
        v4u pk; pk.x = pk2(o[0], o[1]); pk.y = pk2(o[2], o[3]); pk.z = pk2(o[4], o[5]); pk.w = pk2(o[6], o[7]);
        *(v4u*)(ACT + (size_t)(blk * 64 + rr) * DFF + ch0) = pk;
    }
}

__device__ __forceinline__ void p6_final(Ctx& F) {
    const int gw = F.vcu * NWAVES + F.wave, NGW = F.G * NWAVES; const float* SSQ2 = (const float*)(F.ws + WS_SSQ2);
    f32x4 gf[4];
#pragma unroll
    for (int j = 0; j < 4; ++j) gf[j] = ((const f32x4*)F.g_final)[F.lane + 64 * j];
    for (int m = gw; m < TOK; m += NGW) {
        f32x4* xr = (f32x4*)(F.out + (size_t)m * DMODEL) + F.lane; const f32x4* sp = (const f32x4*)(SSQ2 + (size_t)m * 16);
        const f32x4 a = sp[0], b = sp[1], c = sp[2], d = sp[3];
        const float s = (((a[0] + a[1]) + (a[2] + a[3])) + ((b[0] + b[1]) + (b[2] + b[3]))) + (((c[0] + c[1]) + (c[2] + c[3])) + ((d[0] + d[1]) + (d[2] + d[3])));
        const float r = 1.0f / sqrtf(s * (1.0f / DMODEL) + RMS_EPS);
#pragma unroll
        for (int j = 0; j < 4; ++j) { const f32x4 v = xr[64 * j]; xr[64 * j] = v * r * gf[j]; }
    }
}

__global__ void __launch_bounds__(NWAVES * 64, 2) fox_layer_fwd(Args args) {
    extern __shared__ __attribute__((aligned(16))) unsigned char lds[];
    Ctx F;
    F.lds = (LAS unsigned char*)lds;
    volatile LAS unsigned* MISC = (volatile LAS unsigned*)(F.lds + MISC_OFF);
    F.tid = threadIdx.x; F.lane = F.tid & 63; F.wave = __builtin_amdgcn_readfirstlane(F.tid >> 6);
    F.G = gridDim.x; { const int bx = blockIdx.x; F.vcu = (F.G % 8 == 0) ? (bx % 8) * (F.G / 8) + bx / 8 : bx; }
    F.x = args.in[0]; F.g_mix = args.in[1]; F.w_in = args.in[2]; F.b_f = args.in[3]; F.w_conv = args.in[4]; F.g_conv_out = args.in[5]; F.g_attn_out = args.in[6];
    F.w_o = args.in[7]; F.g_ffn = args.in[8]; F.w_up = args.in[9]; F.w_ffn_conv = args.in[10]; F.w_down = args.in[11]; F.g_final = args.in[12];
    F.out = args.out; F.ws = args.ws;
    gu32* ctl = (gu32*)(F.ws + WS_CTL);
    for (int u = F.tid; u < (LDS_BYTES - LDSCTL_OFF) / 4; u += NWAVES * 64) ((LAS unsigned*)(F.lds + LDSCTL_OFF))[u] = 0u;
    __syncthreads();
    XcdBarrier bar = xcd_barrier_post((unsigned*)(ctl + CW_BAR) + args.li * XCD_BAR_WORDS, MISC + 8);
    const int lo = args.ph_lo, hi = args.ph_hi;
#define IN(k) (((MEGA_MASK >> (k)) & 1) && lo <= (k) && (k) < hi)
#define BOTH(k) (IN(k) && IN((k) + 1))
    bf16* const WIN = (bf16*)(F.ws + WS_WIN); bf16* const WO = (bf16*)(F.ws + WS_WO); bf16* const WUP = (bf16*)(F.ws + WS_WUP); bf16* const WDN = (bf16*)(F.ws + WS_WDN);
    bf16* const H1 = (bf16*)(F.ws + WS_H1); bf16* const QKV = (bf16*)(F.ws + WS_QKV); bf16* const MIX = (bf16*)(F.ws + WS_MIX); bf16* const ACT = (bf16*)(F.ws + WS_ACT);

    if (IN(0)) { p0_prologue(F); if (BOTH(0)) xcd_barrier(bar); }

    if (IN(1)) {
        if (blockIdx.x < BATCH * NHEADS) p1_scan(F, (int)blockIdx.x);
        pg8::Gemm g{H1, WIN, TOK, NMAIN, DMODEL}; pg8::StaticOrder S; S.init(TOK, NMAIN, F.G, (int)blockIdx.x);
        pg8::EpiBf16 E{QKV, CONV_CH, CONV_CH, (size_t)(QKV_STRIDE / 2), QSCALE, -1};
        pg8::gemm_phase<pg8::EpiBf16, pg8::StaticOrder, true, true>(F.lds + RING_OFF, g, S, E);
        if (BOTH(1)) xcd_barrier(bar);
    }

    if (IN(2)) {
        p2_conv(F);
        __syncthreads();
        const attn_body::AttnTensors AT{(const attn_body::bf16*)QKV, (const attn_body::bf16*)(F.ws + WS_QKV + QKV_STRIDE), (const attn_body::bf16*)(F.ws + WS_QKV + 2 * QKV_STRIDE),
                                        (const float*)(F.ws + WS_FB), (attn_body::bf16*)MIX, (float*)(F.ws + WS_SSQA)};
        const attn_body::StaticOrder S((int)F.G, (int)blockIdx.x);
        attn_body::attn_phase<attn_body::StaticOrder>((char*)lds + RING_OFF, AT, S);
        if (BOTH(2)) xcd_barrier(bar);
    }

    if (IN(3)) {
        pg8::Gemm g{MIX, WO, TOK, DMODEL, DMODEL}; pg8::StaticOrder S; S.init(TOK, DMODEL, F.G, (int)blockIdx.x);
        pg8::EpiX1 E{F.x, F.out, H1, (float*)(F.ws + WS_SSQ1), (const float*)(F.ws + WS_SSQA), 8};
        pg8::gemm_phase<pg8::EpiX1, pg8::StaticOrder, true, true>(F.lds + RING_OFF, g, S, E);
        if (BOTH(3)) xcd_barrier(bar);
    }

    if (IN(4)) {
        pg8::Gemm g{H1, WUP, TOK, 2 * DFF, DMODEL}; pg8::StaticOrder S; S.init(TOK, 2 * DFF, F.G, (int)blockIdx.x);
        pg8::EpiUp E{ACT, (const float*)(F.ws + WS_SSQ1), F.w_ffn_conv, (float*)(F.ws + WS_HF), (float*)(F.ws + WS_HL), -1};
        pg8::gemm_phase<pg8::EpiUp, pg8::StaticOrder, true, true>(F.lds + RING_OFF, g, S, E);
        xcd_barrier(bar);
        p4_fixup(F);
        if (BOTH(4)) xcd_barrier(bar);
    }

    if (IN(5)) {
        pg8::Gemm g{ACT, WDN, TOK, DMODEL, DFF}; pg8::StaticOrder S; S.init(TOK, DMODEL, F.G, (int)blockIdx.x);
        pg8::EpiDown E{F.out, (float*)(F.ws + WS_SSQ2), -1};
        pg8::gemm_phase<pg8::EpiDown, pg8::StaticOrder, true, true>(F.lds + RING_OFF, g, S, E);
        if (BOTH(5)) xcd_barrier(bar);
    }

    if (IN(6)) p6_final(F);
#undef IN
#undef BOTH
}

namespace nv {
__device__ __forceinline__ float bf2f(bf16 b) { return __uint_as_float((unsigned)b << 16); }
__device__ __forceinline__ bf16 f2b(float f) { return (bf16)f2bf(f); }
__device__ __forceinline__ float block_sum(float v, float* sh) {
    v = wave_sum(v); const int w = threadIdx.x >> 6; __syncthreads(); if ((threadIdx.x & 63) == 0) sh[w] = v; __syncthreads();
    return (sh[0] + sh[1]) + (sh[2] + sh[3]);
}
__global__ void __launch_bounds__(256) s0_rows(const float* x, const float* g, const float* w_in, const float* b_f, bf16* H1, float* LOGF) {
    __shared__ float sh[4]; const int row = blockIdx.x, tid = threadIdx.x; float v[4]; float ss = 0.f;
    for (int i = 0; i < 4; ++i) { v[i] = x[(size_t)row * DMODEL + tid + 256 * i]; ss += v[i] * v[i]; }
    const float rstd = 1.0f / sqrtf(block_sum(ss, sh) * (1.0f / DMODEL) + RMS_EPS);
    float part[8] = {0.f, 0.f, 0.f, 0.f, 0.f, 0.f, 0.f, 0.f};
    for (int i = 0; i < 4; ++i) { const int k = tid + 256 * i; const float h = v[i] * rstd * g[k]; H1[(size_t)row * DMODEL + k] = f2b(h);
        for (int hh = 0; hh < 8; ++hh) part[hh] += h * w_in[(size_t)k * IN_COLS + NMAIN + hh]; }
    for (int hh = 0; hh < 8; ++hh) { const float p = block_sum(part[hh], sh); if (tid == hh) LOGF[(size_t)((row / SEQ) * NHEADS + hh) * SEQ + (row % SEQ)] = log_sigmoid_f(p + b_f[hh]); }
}
__global__ void s1_scan(const float* LOGF, float* FB) { const int bh = blockIdx.x * blockDim.x + threadIdx.x; if (bh >= BATCH * NHEADS) return; float a = 0.f;
    for (int s = 0; s < SEQ; ++s) { a += LOGF[(size_t)bh * SEQ + s]; FB[(size_t)bh * SEQ + s] = -LOG2E * a; } }
template <class Fn> __global__ void __launch_bounds__(256) gemm(Fn f, int K) {
    __shared__ float As[16][65], Bs[16][65];
    const int tid = threadIdx.x, tx = tid & 15, ty = tid >> 4, row0 = blockIdx.y * 64, col0 = blockIdx.x * 64;
    float acc[4][4];
    for (int i = 0; i < 4; ++i) for (int j = 0; j < 4; ++j) acc[i][j] = 0.f;
    for (int k0 = 0; k0 < K; k0 += 16) {
        for (int i = 0; i < 4; ++i) { const int idx = tid + 256 * i; As[idx & 15][idx >> 4] = f.a(row0 + (idx >> 4), k0 + (idx & 15)); }
        for (int i = 0; i < 4; ++i) { const int idx = tid + 256 * i; Bs[idx >> 6][idx & 63] = f.b(k0 + (idx >> 6), col0 + (idx & 63)); }
        __syncthreads();
#pragma unroll
        for (int kk = 0; kk < 16; ++kk) { float a[4], b[4];
#pragma unroll
            for (int i = 0; i < 4; ++i) { a[i] = As[kk][ty * 4 + i]; b[i] = Bs[kk][tx * 4 + i]; }
#pragma unroll
            for (int i = 0; i < 4; ++i)
#pragma unroll
                for (int j = 0; j < 4; ++j) acc[i][j] += a[i] * b[j]; }
        __syncthreads();
    }
    for (int i = 0; i < 4; ++i) for (int j = 0; j < 4; ++j) f.epi(row0 + ty * 4 + i, col0 + tx * 4 + j, acc[i][j]);
}
struct F1 { const bf16* H1; const float* w_in; bf16* QKV;
    __device__ float a(int r, int k) const { return bf2f(H1[(size_t)r * DMODEL + k]); }
    __device__ float b(int k, int c) const { const int ar = c >> 9, j = c & 511; const int sb = (ar == 0) ? 1536 : (ar == 1) ? 2048 : (ar == 2) ? 2560 : (ar == 3) ? 0 : (ar == 4) ? 512 : 1024; return w_in[(size_t)k * IN_COLS + sb + j]; }
    __device__ void epi(int r, int c, float v) const { const int ar = c >> 9, j = c & 511; if (ar == 0) v *= QSCALE; QKV[(size_t)ar * (QKV_STRIDE / 2) + (size_t)r * CONV_CH + j] = f2b(v); } };
__global__ void __launch_bounds__(256) s2_conv(const bf16* GB, const bf16* GC, const bf16* XC, const float* w_conv, const float* gco, bf16* MIX) {
    __shared__ float sh[4]; const int t = blockIdx.x, tid = threadIdx.x, s = t % SEQ; float y[2]; float ss = 0.f;
    for (int i = 0; i < 2; ++i) { const int c = tid + 256 * i; float accv = 0.f;
        for (int j = 0; j < 3; ++j) { const int d = 2 - j; if (s - d >= 0) accv += w_conv[j * CONV_CH + c] * bf2f(GC[(size_t)(t - d) * CONV_CH + c]) * bf2f(XC[(size_t)(t - d) * CONV_CH + c]); }
        y[i] = bf2f(GB[(size_t)t * CONV_CH + c]) * accv; ss += y[i] * y[i]; }
    const float rstd = 1.0f / sqrtf(block_sum(ss, sh) * (1.0f / CONV_CH) + RMS_EPS);
    for (int i = 0; i < 2; ++i) { const int c = tid + 256 * i; MIX[(size_t)t * DMODEL + CONV_CH + c] = f2b(y[i] * rstd * gco[c]); }
}
__global__ void __launch_bounds__(64) s2_attn(const bf16* Q, const bf16* K, const bf16* V, const float* FB, bf16* MIX, float* SSQA) {
    const int bh = blockIdx.y, b = bh / NHEADS, h = bh % NHEADS, t = blockIdx.x * 64 + threadIdx.x; const size_t rb = (size_t)b * SEQ;
    float q[64], o[64];
    for (int d = 0; d < 64; ++d) { q[d] = bf2f(Q[(rb + t) * CONV_CH + h * 64 + d]); o[d] = 0.f; }
    float m = -INFINITY, l = 0.f; const int smax = blockIdx.x * 64 + 63;
    for (int s = 0; s <= smax; ++s) {
        const v4u* kr = (const v4u*)(K + (rb + s) * CONV_CH + h * 64); const v4u* vr = (const v4u*)(V + (rb + s) * CONV_CH + h * 64);
        float sc = 0.f;
#pragma unroll
        for (int c = 0; c < 8; ++c) { const v4u w = kr[c]; sc += q[8 * c] * bflo(w.x) + q[8 * c + 1] * bfhi(w.x) + q[8 * c + 2] * bflo(w.y) + q[8 * c + 3] * bfhi(w.y) + q[8 * c + 4] * bflo(w.z) + q[8 * c + 5] * bfhi(w.z) + q[8 * c + 6] * bflo(w.w) + q[8 * c + 7] * bfhi(w.w); }
        sc += FB[(size_t)bh * SEQ + s];
        if (s <= t) { const float mn = fmaxf(m, sc), f = exp2f(m - mn), p = exp2f(sc - mn); l = l * f + p; m = mn;
#pragma unroll
            for (int c = 0; c < 8; ++c) { const v4u w = vr[c];
                o[8 * c] = o[8 * c] * f + p * bflo(w.x); o[8 * c + 1] = o[8 * c + 1] * f + p * bfhi(w.x); o[8 * c + 2] = o[8 * c + 2] * f + p * bflo(w.y); o[8 * c + 3] = o[8 * c + 3] * f + p * bfhi(w.y);
                o[8 * c + 4] = o[8 * c + 4] * f + p * bflo(w.z); o[8 * c + 5] = o[8 * c + 5] * f + p * bfhi(w.z); o[8 * c + 6] = o[8 * c + 6] * f + p * bflo(w.w); o[8 * c + 7] = o[8 * c + 7] * f + p * bfhi(w.w); } }
    }
    float ss = 0.f; const float rl = 1.0f / l;
    for (int d = 0; d < 64; ++d) { const bf16 ob = f2b(o[d] * rl); MIX[(rb + t) * DMODEL + h * 64 + d] = ob; const float of = bf2f(ob); ss += of * of; }
    SSQA[(rb + t) * NHEADS + h] = ss;
}
__global__ void s3_rattn(const float* SSQA, float* RS) { const int t = blockIdx.x * blockDim.x + threadIdx.x; if (t >= TOK) return; float s = 0.f; for (int h = 0; h < 8; ++h) s += SSQA[(size_t)t * 8 + h]; RS[t] = 1.0f / sqrtf(s * (1.0f / 512.0f) + RMS_EPS); }
struct F3 { const bf16* MIX; const float* RS; const float* g_attn; const float* w_o; const float* x; float* x1; bf16* x1b;
    __device__ float a(int r, int k) const { const float v = bf2f(MIX[(size_t)r * DMODEL + k]); return k < 512 ? v * RS[r] * g_attn[k] : v; }
    __device__ float b(int k, int c) const { return k < 512 ? w_o[(size_t)(512 + k) * DMODEL + c] : w_o[(size_t)(k - 512) * DMODEL + c]; }
    __device__ void epi(int r, int c, float v) const { const float o = x[(size_t)r * DMODEL + c] + v; x1[(size_t)r * DMODEL + c] = o; x1b[(size_t)r * DMODEL + c] = f2b(o); } };
__global__ void __launch_bounds__(256) rows_ssq(const float* X, float* SSQ, float* RS) {
    __shared__ float sh[4]; const int row = blockIdx.x, tid = threadIdx.x; float ss = 0.f;
    for (int i = 0; i < 4; ++i) { const float v = X[(size_t)row * DMODEL + tid + 256 * i]; ss += v * v; }
    ss = block_sum(ss, sh); if (tid < 16) SSQ[(size_t)row * 16 + tid] = tid == 0 ? ss : 0.f; if (RS && tid == 0) RS[row] = 1.0f / sqrtf(ss * (1.0f / DMODEL) + RMS_EPS);
}
struct F4 { const bf16* X1B; const float* RS; const float* g_ffn; const float* w_up; bf16* UU; int rb;
    __device__ float a(int r, int k) const { return bf2f(X1B[(size_t)(rb + r) * DMODEL + k]); }
    __device__ float b(int k, int c) const { return g_ffn[k] * w_up[(size_t)k * (2 * DFF) + c]; }
    __device__ void epi(int r, int c, float v) const { UU[(size_t)r * (2 * DFF) + c] = f2b(v * RS[rb + r]); } };
__global__ void __launch_bounds__(256) s4_gate(const bf16* UU, const float* wc, bf16* ACT, int rb) {
    const size_t i = (size_t)blockIdx.x * 256 + threadIdx.x; if (i >= (size_t)SEQ * DFF) return; const int s = (int)(i / DFF), c = (int)(i % DFF); float ua = 0.f, ug = 0.f;
    for (int j = 0; j < 3; ++j) { const int d = 2 - j; if (s - d >= 0) { ua += wc[(size_t)j * (2 * DFF) + c] * bf2f(UU[(size_t)(s - d) * (2 * DFF) + c]); ug += wc[(size_t)j * (2 * DFF) + DFF + c] * bf2f(UU[(size_t)(s - d) * (2 * DFF) + DFF + c]); } }
    ACT[(size_t)(rb + s) * DFF + c] = f2b(ua * ug / (1.0f + expf(-ug)));
}
struct F5 { const bf16* ACT; const float* w_down; float* xio;
    __device__ float a(int r, int k) const { return bf2f(ACT[(size_t)r * DFF + k]); }
    __device__ float b(int k, int c) const { return w_down[(size_t)k * DMODEL + c]; }
    __device__ void epi(int r, int c, float v) const { xio[(size_t)r * DMODEL + c] += v; } };
__global__ void __launch_bounds__(256) s6_final(float* X, const float* SSQ2, const float* gf) {
    const int row = blockIdx.x, tid = threadIdx.x; float s = 0.f; for (int i = 0; i < 16; ++i) s += SSQ2[(size_t)row * 16 + i];
    const float r = 1.0f / sqrtf(s * (1.0f / DMODEL) + RMS_EPS);
    for (int i = 0; i < 4; ++i) { const int k = tid + 256 * i; X[(size_t)row * DMODEL + k] = X[(size_t)row * DMODEL + k] * r * gf[k]; }
}
}

extern "C" void kernel_launch(void* const* d_in, const int* in_sizes, int n_in, void* d_out, int out_size, void* d_ws, size_t ws_size, hipStream_t stream) {
    static int grid = 0;
    if (grid == 0) {
        if (n_in != 13 || in_sizes[0] != TOK * DMODEL || out_size != TOK * DMODEL || ws_size < WS_END) { fprintf(stderr, "kernel_launch: built for 13 inputs, x/out of %d floats, >= %zu bytes of workspace; got n_in %d, in0 %d, out %d, ws %zu; nothing launched\n", TOK * DMODEL, (size_t)WS_END, n_in, n_in > 0 ? in_sizes[0] : -1, out_size, ws_size); grid = -1; return; }
        int dev = 0, cus = 0, per_cu = 0;
        if (hipGetDevice(&dev) != hipSuccess || hipDeviceGetAttribute(&cus, hipDeviceAttributeMultiprocessorCount, dev) != hipSuccess) { fprintf(stderr, "kernel_launch: device query failed\n"); grid = -1; return; }
        if (hipFuncSetAttribute((const void*)fox_layer_fwd, hipFuncAttributeMaxDynamicSharedMemorySize, LDS_BYTES) != hipSuccess) { fprintf(stderr, "kernel_launch: hipFuncSetAttribute failed\n"); grid = -1; return; }
        if (hipOccupancyMaxActiveBlocksPerMultiprocessor(&per_cu, (const void*)fox_layer_fwd, NWAVES * 64, LDS_BYTES) != hipSuccess || per_cu < 1)
            fprintf(stderr, "kernel_launch: note: the occupancy query reports %d workgroups per CU\n", per_cu);
        (void)hipGetLastError();
        grid = cus;
    }
    if (grid < 0) return;
    if (hipMemsetAsync((char*)d_ws + WS_CTL, 0, CTL_ZERO_BYTES, stream) != hipSuccess) { fprintf(stderr, "kernel_launch: hipMemsetAsync failed\n"); return; }
    Args a{};
    for (int i = 0; i < 13; ++i) a.in[i] = (const float*)d_in[i];
    a.out = (float*)d_out; a.ws = (unsigned char*)d_ws;
    unsigned char* ws = (unsigned char*)d_ws; float* out = (float*)d_out;
    const float *x = a.in[0], *g_mix = a.in[1], *w_in = a.in[2], *b_f = a.in[3], *w_conv = a.in[4], *g_conv_out = a.in[5], *g_attn_out = a.in[6], *w_o = a.in[7], *g_ffn = a.in[8], *w_up = a.in[9], *w_ffn_conv = a.in[10], *w_down = a.in[11], *g_final = a.in[12];
    (void)g_mix; (void)w_in; (void)b_f; (void)w_conv; (void)g_conv_out; (void)g_attn_out; (void)w_o; (void)g_ffn; (void)w_up; (void)w_ffn_conv; (void)w_down; (void)g_final; (void)x; (void)out; (void)ws;
    int li = 0;
    for (int s = 0; s < 7;) {
        if ((MEGA_MASK >> s) & 1) {
            int e = s; while (e < 7 && ((MEGA_MASK >> e) & 1)) ++e;
            a.ph_lo = s; a.ph_hi = e; a.li = li++;
            hipLaunchKernelGGL(fox_layer_fwd, dim3(grid), dim3(NWAVES * 64), LDS_BYTES, stream, a);
            const hipError_t le = hipPeekAtLastError();
            if (le != hipSuccess) { fprintf(stderr, "kernel_launch: launch failed: %s\n", hipGetErrorName(le)); return; }
            s = e; continue;
        }
#if MEGA_MASK != 0x7F
        bf16* H1 = (bf16*)(ws + WS_H1); bf16* QKV = (bf16*)(ws + WS_QKV); bf16* MIX = (bf16*)(ws + WS_MIX); bf16* ACT = (bf16*)(ws + WS_ACT); bf16* UU = (bf16*)(ws + WS_UU); float* RS = (float*)(ws + WS_RS);
        float* LOGF = (float*)(ws + WS_LOGF); float* FB = (float*)(ws + WS_FB); float* SSQA = (float*)(ws + WS_SSQA); float* SSQ1 = (float*)(ws + WS_SSQ1); float* SSQ2 = (float*)(ws + WS_SSQ2);
        switch (s) {
        case 0: hipLaunchKernelGGL(nv::s0_rows, dim3(TOK), dim3(256), 0, stream, x, g_mix, w_in, b_f, H1, LOGF); break;
        case 1: hipLaunchKernelGGL(nv::s1_scan, dim3(1), dim3(64), 0, stream, (const float*)LOGF, FB);
                hipLaunchKernelGGL(nv::gemm<nv::F1>, dim3(NMAIN / 64, TOK / 64), dim3(256), 0, stream, nv::F1{H1, w_in, QKV}, DMODEL); break;
        case 2: hipLaunchKernelGGL(nv::s2_conv, dim3(TOK), dim3(256), 0, stream, (const bf16*)(QKV + 3 * (QKV_STRIDE / 2)), (const bf16*)(QKV + 4 * (QKV_STRIDE / 2)), (const bf16*)(QKV + 5 * (QKV_STRIDE / 2)), w_conv, g_conv_out, MIX);
                hipLaunchKernelGGL(nv::s2_attn, dim3(SEQ / 64, BATCH * NHEADS), dim3(64), 0, stream, (const bf16*)QKV, (const bf16*)(QKV + (QKV_STRIDE / 2)), (const bf16*)(QKV + 2 * (QKV_STRIDE / 2)), (const float*)FB, MIX, SSQA); break;
        case 3: hipLaunchKernelGGL(nv::s3_rattn, dim3(TOK / 256), dim3(256), 0, stream, (const float*)SSQA, RS);
                hipLaunchKernelGGL(nv::gemm<nv::F3>, dim3(DMODEL / 64, TOK / 64), dim3(256), 0, stream, nv::F3{MIX, RS, g_attn_out, w_o, x, out, H1}, DMODEL);
                hipLaunchKernelGGL(nv::rows_ssq, dim3(TOK), dim3(256), 0, stream, (const float*)out, SSQ1, (float*)nullptr); break;
        case 4: hipLaunchKernelGGL(nv::rows_ssq, dim3(TOK), dim3(256), 0, stream, (const float*)out, SSQ1, RS);
                for (int b = 0; b < BATCH; ++b) {
                    hipLaunchKernelGGL(nv::gemm<nv::F4>, dim3(2 * DFF / 64, SEQ / 64), dim3(256), 0, stream, nv::F4{H1, RS, g_ffn, w_up, UU, b * SEQ}, DMODEL);
                    hipLaunchKernelGGL(nv::s4_gate, dim3((unsigned)(((size_t)SEQ * DFF + 255) / 256)), dim3(256), 0, stream, (const bf16*)UU, w_ffn_conv, ACT, b * SEQ); }
                break;
        case 5: hipLaunchKernelGGL(nv::gemm<nv::F5>, dim3(DMODEL / 64, TOK / 64), dim3(256), 0, stream, nv::F5{ACT, w_down, out}, DFF);
                hipLaunchKernelGGL(nv::rows_ssq, dim3(TOK), dim3(256), 0, stream, (const float*)out, SSQ2, (float*)nullptr); break;
        case 6: hipLaunchKernelGGL(nv::s6_final, dim3(TOK), dim3(256), 0, stream, out, (const float*)SSQ2, g_final); break;
        }
#endif
        ++s;
    }
}
```

```cpp
#include <hip/hip_runtime.h>
#include <hip/hip_bf16.h>
#include <cstdio>
#include <cstdint>
#include <cmath>

#ifndef MEGA_MASK
#define MEGA_MASK 0x7F
#endif
#ifndef REPEAT_MASK
#define REPEAT_MASK 0x00
#endif

constexpr int BATCH = 4, SEQ = 8192, DMODEL = 1024, TOK = BATCH * SEQ;
constexpr int CONV_CH = 512, NHEADS = 8, HEAD_DIM = 64, ATTN_W = 512, DFF = 2816, IN_COLS = 3080, NMAIN = 3072;
constexpr float RMS_EPS = 1e-6f;
constexpr float LOG2E = 1.4426950408889634f;
constexpr float QSCALE = 0.125f * LOG2E;

constexpr size_t MiB = 1u << 20;
constexpr size_t WS_CTL = 0, CTL_ZERO_BYTES = 1 * MiB;
constexpr size_t WS_WIN = 2 * MiB;
constexpr size_t WS_WO = 8 * MiB;
constexpr size_t WS_WUP = 10 * MiB;
constexpr size_t WS_WDN = 21 * MiB;
constexpr size_t WS_FB = 27 * MiB;
constexpr size_t WS_LOGF = 28 * MiB;
constexpr size_t WS_SSQA = 29 * MiB;
constexpr size_t WS_SSQ1 = 30 * MiB;
constexpr size_t WS_SSQ2 = 32 * MiB;
constexpr size_t WS_HF = 34 * MiB;
constexpr size_t WS_HL = 56 * MiB;
constexpr size_t WS_H1 = 80 * MiB;
constexpr size_t WS_QKV = 144 * MiB;
constexpr size_t QKV_STRIDE = 32 * MiB;
constexpr size_t WS_ACT = 144 * MiB;
constexpr size_t WS_MIX = 336 * MiB;
constexpr size_t WS_UU = 400 * MiB;
constexpr size_t WS_RS = 496 * MiB;
constexpr size_t WS_END = 500 * MiB;
static_assert(WS_WUP + (size_t)2 * DFF * DMODEL * 2 <= WS_WDN && WS_WDN + (size_t)DMODEL * DFF * 2 <= WS_FB && WS_HF + (size_t)512 * 2 * 2 * DFF * 4 <= WS_HL && WS_HL + (size_t)512 * 2 * 2 * DFF * 4 <= WS_H1, "d_ws map");
static_assert(WS_ACT + (size_t)TOK * DFF * 2 <= WS_MIX && WS_UU + (size_t)SEQ * 2 * DFF * 2 <= WS_RS, "d_ws map");
constexpr int CW_TMO = 0, CW_CODE = 1;
constexpr int CW_KN2 = 2048;
constexpr int CW_BAR = 4096;

namespace pg8 {
#define PG8_LAS __attribute__((address_space(3)))
typedef unsigned short bf16_t;
typedef short bf16x8 __attribute__((ext_vector_type(8)));
typedef float f32x4 __attribute__((ext_vector_type(4)));
typedef unsigned u32x4 __attribute__((ext_vector_type(4)));
constexpr int BM = 256, BK = 64, HALF = 128, HTB = HALF * BK * 2  , STAGE_BYTES = 8 * HTB, NXCD = 8, WGM = 8;

__host__ __device__ __forceinline__ int lds_byte(int r, int c) { const int st = (r >> 4) * 2 + (c >> 5), rr = r & 15, cc = c & 31, ob = rr * 64 + cc * 2; return st * 1024 + (ob ^ (((ob >> 9) & 1) << 5)); }
__host__ __device__ __forceinline__ void stage_rc(int b, int& R, int& C) { const int st = b / 1024, sb = b % 1024, swz = sb ^ (((sb >> 9) & 1) << 5); R = (st >> 1) * 16 + swz / 64; C = (st & 1) * 32 + (swz % 64) / 2; }
__host__ __device__ __forceinline__ int perm32(int rho) { const int n = rho >> 4, i = rho & 15; return 8 * (i >> 2) + 4 * n + (i & 3); }

struct Unit { int pm, pn; };
struct Gemm { const bf16_t* A; const bf16_t* Bt; int M, N, K; };

struct StaticOrder {
    int nM, nN, nwg, G, c;
    __host__ __device__ void init(int M, int N, int G_, int c_) { nM = M / BM; nN = N / BM; nwg = nM * nN; G = G_; c = c_; }
    __host__ __device__ bool next(int i, Unit& u) const {
        const long L = (long)i * G + c; if (L >= nwg) return false;
        int wgid = (int)L; { const int q = nwg / NXCD, r = nwg % NXCD, xcd = wgid % NXCD, off = wgid / NXCD; wgid = (xcd < r ? xcd * (q + 1) : r * (q + 1) + (xcd - r) * q) + off; }
        const int nig = WGM * nN, gid = wgid / nig, fm = gid * WGM, gsz = (nM - fm) < WGM ? (nM - fm) : WGM;
        u.pm = fm + ((wgid % nig) % gsz); u.pn = (wgid % nig) / gsz; return true;
    }
    __device__ __forceinline__ void a_ready(const Unit&) const {}
    __device__ __forceinline__ void done(const Unit&) const {}
};


__device__ __forceinline__ unsigned cvt_pk_bf16(float lo, float hi) { unsigned r; asm volatile("v_cvt_pk_bf16_f32 %0, %1, %2" : "=v"(r) : "v"(lo), "v"(hi)); return r; }
typedef unsigned u32x2 __attribute__((ext_vector_type(2)));
template <int CTRL> __device__ __forceinline__ float dpp_mov(float old, float src) {
    return __builtin_bit_cast(float, __builtin_amdgcn_update_dpp(__builtin_bit_cast(int, old), __builtin_bit_cast(int, src), CTRL, 0xf, 0xf, false)); }
constexpr int DPP_SHR1 = 0x111, DPP_SHR2 = 0x112, DPP_ROR1 = 0x121, DPP_ROR2 = 0x122;

struct EpiBf16 {
    static constexpr bool PERM = true, AFTER_DRAIN = false, MIDHOOK = false;
    bf16_t* O; int ldc; int split_cols; size_t split_stride; float scale0; unsigned* kn2; int mid_t;
    __device__ __forceinline__ void mid(f32x4 (&)[2][2][4][2], const Unit&, int, int) const {}
    __device__ __forceinline__ void operator()(const f32x4 (&acc)[2][2][4][2], const Unit& u, int wr, int wc, int fr, int fq) const {
        const int row0 = u.pm * BM + wr * 64 + fr; int colt = u.pn * BM; bf16_t* base = O;
        float sc = 1.f; const int t = colt / split_cols; { base += (size_t)t * split_stride; colt -= t * split_cols; if (t == 0) sc = scale0; }
        const int col0 = colt + wc * 32 + 8 * fq;
#pragma unroll
        for (int ai = 0; ai < 2; ++ai)
#pragma unroll
            for (int m = 0; m < 4; ++m) { bf16_t* rowp = base + (size_t)(row0 + ai * HALF + m * 16) * ldc + col0;
#pragma unroll
                for (int bj = 0; bj < 2; ++bj) { f32x4 v0 = acc[ai][bj][m][0] * sc, v1 = acc[ai][bj][m][1] * sc;
                    u32x4 w; w.x = cvt_pk_bf16(v0[0], v0[1]); w.y = cvt_pk_bf16(v0[2], v0[3]); w.z = cvt_pk_bf16(v1[0], v1[1]); w.w = cvt_pk_bf16(v1[2], v1[3]);
                    *(u32x4*)(rowp + bj * HALF) = w; } }
        if (t == 1 && kn2) {
#pragma unroll
            for (int bj = 0; bj < 2; ++bj) { float mx = 0.f;
#pragma unroll
                for (int ai = 0; ai < 2; ++ai)
#pragma unroll
                    for (int m = 0; m < 4; ++m) { float ss = 0.f;
#pragma unroll
                        for (int n = 0; n < 2; ++n) { const f32x4 v = acc[ai][bj][m][n]; ss += (v[0] * v[0] + v[1] * v[1]) + (v[2] * v[2] + v[3] * v[3]); }
                        ss += __shfl_xor(ss, 16); ss += __shfl_xor(ss, 32); mx = fmaxf(mx, ss); }
                mx = fmaxf(mx, __shfl_xor(mx, 1)); mx = fmaxf(mx, __shfl_xor(mx, 2)); mx = fmaxf(mx, __shfl_xor(mx, 4)); mx = fmaxf(mx, __shfl_xor(mx, 8));
                const int head = (colt >> 6) + 2 * bj + (wc >> 1);
                if (fr == 0 && fq == 0) atomicMax(kn2 + ((u.pm >> 5) * NHEADS + head) * 2 + (wc & 1), __float_as_uint(mx)); }
        }
    }
};

struct EpiX1 {
    static constexpr bool PERM = false, AFTER_DRAIN = false, MIDHOOK = true;
    const float* x; float* x1; bf16_t* x1b; float* ssq1; const float* ssqa; int mid_t;
    __device__ __forceinline__ void mid(f32x4 (&acc)[2][2][4][2], const Unit& u, int wr, int fr) const {
        asm volatile("" : "+v"(fr));
#pragma unroll
        for (int ai = 0; ai < 2; ++ai)
#pragma unroll
            for (int m = 0; m < 4; ++m) { const int row = u.pm * BM + ai * HALF + wr * 64 + m * 16 + fr;
                const f32x4 s0 = *(const f32x4*)(ssqa + (size_t)row * 8), s1 = *(const f32x4*)(ssqa + (size_t)row * 8 + 4);
                const float s = ((s0[0] + s0[1]) + (s0[2] + s0[3])) + ((s1[0] + s1[1]) + (s1[2] + s1[3]));
                float r = __builtin_amdgcn_rsqf(s * (1.0f / 512.0f) + RMS_EPS);
                asm volatile("" : "+v"(r) :: "memory");
#pragma unroll
                for (int bj = 0; bj < 2; ++bj)
#pragma unroll
                    for (int n = 0; n < 2; ++n) acc[ai][bj][m][n] = acc[ai][bj][m][n] * r; }
    }
    __device__ __forceinline__ void operator()(const f32x4 (&acc)[2][2][4][2], const Unit& u, int wr, int wc, int fr, int fq) const {
        asm volatile("" : "+v"(fr), "+v"(fq));
        const int row0 = u.pm * BM + wr * 64 + fr, col0 = u.pn * BM + wc * 32 + 4 * fq;
#pragma unroll
        for (int ai = 0; ai < 2; ++ai)
#pragma unroll
            for (int m = 0; m < 4; ++m) { const int row = row0 + ai * HALF + m * 16; float ss = 0.f;
#pragma unroll
                for (int bj = 0; bj < 2; ++bj)
#pragma unroll
                    for (int n = 0; n < 2; ++n) { const size_t off = (size_t)row * DMODEL + col0 + bj * HALF + n * 16;
                        const f32x4 v = *(const f32x4*)(x + off) + acc[ai][bj][m][n];
                        *(f32x4*)(x1 + off) = v;
                        u32x2 w; w.x = cvt_pk_bf16(v[0], v[1]); w.y = cvt_pk_bf16(v[2], v[3]); *(u32x2*)(x1b + off) = w;
                        ss += (v[0] * v[0] + v[1] * v[1]) + (v[2] * v[2] + v[3] * v[3]); }
                ss += __shfl_xor(ss, 16); ss += __shfl_xor(ss, 32);
                if (fq == 0) ssq1[(size_t)row * 16 + u.pn * 4 + wc] = ss;
                asm volatile("" ::: "memory"); }
    }
};

struct EpiDown {
    static constexpr bool PERM = false, AFTER_DRAIN = false, MIDHOOK = false;
    float* xio; float* ssq2; int mid_t;
    __device__ __forceinline__ void mid(f32x4 (&)[2][2][4][2], const Unit&, int, int) const {}
    __device__ __forceinline__ void operator()(const f32x4 (&acc)[2][2][4][2], const Unit& u, int wr, int wc, int fr, int fq) const {
        asm volatile("" : "+v"(fr), "+v"(fq));
        const int row0 = u.pm * BM + wr * 64 + fr, col0 = u.pn * BM + wc * 32 + 4 * fq;
#pragma unroll
        for (int ai = 0; ai < 2; ++ai)
#pragma unroll
            for (int m = 0; m < 4; ++m) { const int row = row0 + ai * HALF + m * 16; float ss = 0.f;
#pragma unroll
                for (int bj = 0; bj < 2; ++bj)
#pragma unroll
                    for (int n = 0; n < 2; ++n) { const size_t off = (size_t)row * DMODEL + col0 + bj * HALF + n * 16;
                        const f32x4 v = *(const f32x4*)(xio + off) + acc[ai][bj][m][n];
                        *(f32x4*)(xio + off) = v;
                        ss += (v[0] * v[0] + v[1] * v[1]) + (v[2] * v[2] + v[3] * v[3]); }
                ss += __shfl_xor(ss, 16); ss += __shfl_xor(ss, 32);
                if (fq == 0) ssq2[(size_t)row * 16 + u.pn * 4 + wc] = ss;
                asm volatile("" ::: "memory"); }
    }
};

struct EpiUp {
    static constexpr bool PERM = true, AFTER_DRAIN = false, MIDHOOK = false;
    bf16_t* act; const float* ssq1; const float* wconv; float* hf; float* hl; int mid_t;
    __device__ __forceinline__ void mid(f32x4 (&)[2][2][4][2], const Unit&, int, int) const {}
    __device__ __forceinline__ void operator()(f32x4 (&acc)[2][2][4][2], const Unit& u, int wr, int wc, int fr, int fq) const {
        asm volatile("" : "+v"(fr), "+v"(fq));
        const int ch0 = u.pn * 128 + wc * 32 + 8 * fq;
#pragma unroll
        for (int ai = 0; ai < 2; ++ai) {
#pragma unroll
            for (int m = 0; m < 4; ++m) { const int row = u.pm * BM + ai * HALF + wr * 64 + m * 16 + fr; const f32x4* sp = (const f32x4*)(ssq1 + (size_t)row * 16);
                const f32x4 a = sp[0], b = sp[1], c = sp[2], d = sp[3];
                const float s = (((a[0] + a[1]) + (a[2] + a[3])) + ((b[0] + b[1]) + (b[2] + b[3]))) + (((c[0] + c[1]) + (c[2] + c[3])) + ((d[0] + d[1]) + (d[2] + d[3])));
                float r = __builtin_amdgcn_rsqf(s * (1.0f / 1024.0f) + RMS_EPS);
                asm volatile("" : "+v"(r) :: "memory");
#pragma unroll
                for (int bj = 0; bj < 2; ++bj)
#pragma unroll
                    for (int n = 0; n < 2; ++n) acc[ai][bj][m][n] = acc[ai][bj][m][n] * r; }
            __builtin_amdgcn_sched_barrier(0);
            const int blk = u.pm * 4 + ai * 2 + wr;
            if (fr < 2) {
#pragma unroll
                for (int bj = 0; bj < 2; ++bj)
#pragma unroll
                    for (int n = 0; n < 2; ++n) *(f32x4*)(hf + ((size_t)(blk * 2 + fr) * 2 + bj) * DFF + ch0 + 4 * n) = acc[ai][bj][0][n]; }
            if (fr >= 14) {
#pragma unroll
                for (int bj = 0; bj < 2; ++bj)
#pragma unroll
                    for (int n = 0; n < 2; ++n) *(f32x4*)(hl + ((size_t)(blk * 2 + (fr - 14)) * 2 + bj) * DFF + ch0 + 4 * n) = acc[ai][bj][3][n]; }
            __builtin_amdgcn_sched_barrier(0);
#pragma unroll
            for (int bj = 0; bj < 2; ++bj)
#pragma unroll
                for (int n = 0; n < 2; ++n) {
                    const f32x4 w0 = *(const f32x4*)(wconv + bj * DFF + ch0 + 4 * n), w1 = *(const f32x4*)(wconv + (size_t)(2 * DFF) + bj * DFF + ch0 + 4 * n), w2 = *(const f32x4*)(wconv + (size_t)(4 * DFF) + bj * DFF + ch0 + 4 * n);
#pragma unroll
                    for (int m = 3; m >= 0; --m) {
                        if (m > 0) asm volatile("" : "+v"(acc[ai][bj][m][n]), "+v"(acc[ai][bj][m - 1][n])); else asm volatile("" : "+v"(acc[ai][bj][m][n]));
                        f32x4 res;
#pragma unroll
                        for (int j = 0; j < 4; ++j) {
                            const float cur = acc[ai][bj][m][n][j];
                            float o1 = 0.f, o2 = 0.f;
                            if (m > 0) { const float prv = acc[ai][bj][m - 1][n][j]; o1 = dpp_mov<DPP_ROR1>(0.f, prv); o2 = dpp_mov<DPP_ROR2>(0.f, prv); }
                            const float s1 = dpp_mov<DPP_SHR1>(o1, cur), s2 = dpp_mov<DPP_SHR2>(o2, cur);
                            res[j] = w2[j] * cur + w1[j] * s1 + w0[j] * s2; }
                        acc[ai][bj][m][n] = res; asm volatile("" : "+v"(acc[ai][bj][m][n])); }
                    asm volatile("" ::: "memory"); __builtin_amdgcn_sched_barrier(0);
                }
#pragma unroll
            for (int m = 0; m < 4; ++m) {
                float o[8];
#pragma unroll
                for (int n = 0; n < 2; ++n)
#pragma unroll
                    for (int j = 0; j < 4; ++j) { const float a = acc[ai][0][m][n][j], g = acc[ai][1][m][n][j]; const float e = __builtin_amdgcn_exp2f(-g * LOG2E); o[4 * n + j] = a * g * __builtin_amdgcn_rcpf(1.0f + e); }
                u32x4 pk; pk.x = cvt_pk_bf16(o[0], o[1]); pk.y = cvt_pk_bf16(o[2], o[3]); pk.z = cvt_pk_bf16(o[4], o[5]); pk.w = cvt_pk_bf16(o[6], o[7]);
                const int row = u.pm * BM + ai * HALF + wr * 64 + m * 16 + fr;
                *(u32x4*)(act + (size_t)row * DFF + ch0) = pk; __builtin_amdgcn_sched_barrier(0); }
        }
    }
};

template <class Epi, class Sched, bool ALIGN_EPI = false, bool SP2 = false>
__device__ __forceinline__ void gemm_phase(PG8_LAS unsigned char* lds, const Gemm g, const Sched& S, const Epi& E) {
    const int tid = threadIdx.x, wid = __builtin_amdgcn_readfirstlane(tid >> 6), lane = tid & 63, wr = wid >> 2, wc = wid & 3, fr = lane & 15, fq = lane >> 4;
    const int K = g.K, nt = K / BK;
    unsigned voffA[2], voffB[2];
#pragma unroll
    for (int i = 0; i < 2; ++i) { int R, C; stage_rc(tid * 16 + i * 8192, R, C); const int Rb = Epi::PERM ? ((R & ~31) + perm32(R & 31)) : R;
        voffA[i] = (unsigned)(R * K + C) * 2u; voffB[i] = (unsigned)(Rb * K + C) * 2u; }
    const size_t kstep = (size_t)(BK * 2);
    const size_t hstep = (size_t)HALF * K * 2;
    const size_t tstep = 2 * hstep;
    const unsigned ldsw = (unsigned)wid * 1024u;
    const int aoff = lds_byte(wr * 64 + fr, fq * 8), boff = lds_byte(wc * 32 + fr, fq * 8);
#define PG8_SA(b, h) (((b) * 2 + (h)) * HTB)
#define PG8_SB(b, h) ((4 + (b) * 2 + (h)) * HTB)
#define PG8_STAGE(bufoff, gbase, voff) do { _Pragma("unroll") for (int _i = 0; _i < 2; ++_i) \
        __builtin_amdgcn_global_load_lds((const unsigned*)((const char*)(gbase) + (voff)[_i]), (PG8_LAS unsigned*)(lds + (bufoff) + ldsw + _i * 8192), 16, 0, 0); } while (0)
#define PG8_LDA(dst, b, h) do { _Pragma("unroll") for (int m = 0; m < 4; ++m) _Pragma("unroll") for (int k = 0; k < 2; ++k) dst[m][k] = *(const PG8_LAS bf16x8*)(lds + PG8_SA(b, h) + aoff + m * 2048 + k * 1024); } while (0)
#define PG8_LDB(dst, b, h) do { _Pragma("unroll") for (int n = 0; n < 2; ++n) _Pragma("unroll") for (int k = 0; k < 2; ++k) dst[n][k] = *(const PG8_LAS bf16x8*)(lds + PG8_SB(b, h) + boff + n * 2048 + k * 1024); } while (0)
#define PG8_MMA(ai, bj, At, Bt) do { __builtin_amdgcn_s_setprio(1); _Pragma("unroll") for (int m = 0; m < 4; ++m) _Pragma("unroll") for (int n = 0; n < 2; ++n) _Pragma("unroll") for (int k = 0; k < 2; ++k) \
        acc[ai][bj][m][n] = __builtin_amdgcn_mfma_f32_16x16x32_bf16(Bt[n][k], At[m][k], acc[ai][bj][m][n], 0, 0, 0); __builtin_amdgcn_s_setprio(0); } while (0)
#define PG8_WAIT_V(n) asm volatile("s_waitcnt vmcnt(" #n ")" ::: "memory")
#define PG8_WAIT_L(n) asm volatile("s_waitcnt lgkmcnt(" #n ")" ::: "memory")
#define PG8_BAR __builtin_amdgcn_s_barrier()
#define PG8_SCHED __builtin_amdgcn_sched_barrier(0)
    Unit cur, nxt; int ui = 0;
    if (!S.next(0, cur)) return;
    f32x4 acc[2][2][4][2];
#pragma unroll
    for (int a = 0; a < 2; ++a)
#pragma unroll
        for (int b = 0; b < 2; ++b)
#pragma unroll
            for (int m = 0; m < 4; ++m)
#pragma unroll
                for (int n = 0; n < 2; ++n) acc[a][b][m][n] = (f32x4){0.f, 0.f, 0.f, 0.f};
    bf16x8 At[4][2], B0[2][2], B1[2][2];
    const char* cA = (const char*)g.A + (size_t)cur.pm * tstep; const char* cB = (const char*)g.Bt + (size_t)cur.pn * tstep;
    S.a_ready(cur);
    if constexpr (SP2) {
        PG8_STAGE(PG8_SB(0, 0), cB, voffB); PG8_STAGE(PG8_SB(0, 1), cB + hstep, voffB); PG8_STAGE(PG8_SA(0, 0), cA, voffA); PG8_STAGE(PG8_SA(0, 1), cA + hstep, voffA);
        if (wr == 1) PG8_BAR;
        PG8_WAIT_V(2); PG8_BAR;
        PG8_STAGE(PG8_SB(1, 0), cB + kstep, voffB); PG8_STAGE(PG8_SA(1, 0), cA + kstep, voffA); PG8_STAGE(PG8_SB(1, 1), cB + hstep + kstep, voffB);
        PG8_WAIT_V(6); PG8_BAR;
    } else {
        PG8_STAGE(PG8_SB(0, 0), cB, voffB); PG8_STAGE(PG8_SA(0, 0), cA, voffA); PG8_STAGE(PG8_SB(0, 1), cB + hstep, voffB); PG8_STAGE(PG8_SA(0, 1), cA + hstep, voffA);
        if (wr == 1) PG8_BAR;
        PG8_WAIT_V(4); PG8_BAR;
        PG8_STAGE(PG8_SB(1, 0), cB + kstep, voffB); PG8_STAGE(PG8_SA(1, 0), cA + kstep, voffA); PG8_STAGE(PG8_SB(1, 1), cB + hstep + kstep, voffB);
        PG8_WAIT_V(6); PG8_BAR;
    }
    for (;;) {
        const bool has_next = S.next(ui + 1, nxt);
        const char* nA = has_next ? (const char*)g.A + (size_t)nxt.pm * tstep : cA; const char* nB = has_next ? (const char*)g.Bt + (size_t)nxt.pn * tstep : cB;
        for (int t = 0; t < nt; t += 2) {
            if constexpr (Epi::MIDHOOK) { if (t == E.mid_t) E.mid(acc, cur, wr, fr); }
            const bool last = (t == nt - 2);
            const char* a1 = cA + (size_t)(t + 1) * kstep;
            const char* a2 = last ? nA : cA + (size_t)(t + 2) * kstep; const char* b2 = last ? nB : cB + (size_t)(t + 2) * kstep;
            const char* a3 = a2 + kstep; const char* b3 = b2 + kstep;
            if (last && has_next) S.a_ready(nxt);
            if constexpr (SP2) {
            PG8_LDB(B0, 0, 0); PG8_LDB(B1, 0, 1); PG8_SCHED; PG8_LDA(At, 0, 0); PG8_STAGE(PG8_SA(1, 1), a1 + hstep, voffA);
            PG8_WAIT_V(8); PG8_WAIT_L(0); PG8_BAR; PG8_MMA(0, 0, At, B0); PG8_MMA(0, 1, At, B1); PG8_BAR; PG8_SCHED;
            PG8_LDA(At, 0, 1); PG8_STAGE(PG8_SB(0, 0), b2, voffB); PG8_STAGE(PG8_SB(0, 1), b2 + hstep, voffB); PG8_STAGE(PG8_SA(0, 0), a2, voffA);
            PG8_WAIT_V(8); PG8_WAIT_L(0); PG8_BAR; PG8_MMA(1, 0, At, B0); PG8_MMA(1, 1, At, B1); PG8_BAR; PG8_SCHED;
            PG8_LDB(B0, 1, 0); PG8_LDB(B1, 1, 1); PG8_SCHED; PG8_LDA(At, 1, 0); PG8_STAGE(PG8_SA(0, 1), a2 + hstep, voffA);
            PG8_WAIT_V(8); PG8_WAIT_L(0); PG8_BAR; PG8_MMA(0, 0, At, B0); PG8_MMA(0, 1, At, B1); PG8_BAR; PG8_SCHED;
            PG8_LDA(At, 1, 1); PG8_STAGE(PG8_SB(1, 0), b3, voffB); PG8_STAGE(PG8_SB(1, 1), b3 + hstep, voffB); PG8_STAGE(PG8_SA(1, 0), a3, voffA);
            PG8_WAIT_V(8); PG8_WAIT_L(0); PG8_BAR; PG8_MMA(1, 0, At, B0); PG8_MMA(1, 1, At, B1); PG8_BAR; PG8_SCHED;
            } else {
            PG8_LDB(B0, 0, 0); PG8_SCHED; PG8_LDA(At, 0, 0); PG8_STAGE(PG8_SA(1, 1), a1 + hstep, voffA);
            PG8_WAIT_L(8); PG8_BAR; PG8_WAIT_L(0); PG8_MMA(0, 0, At, B0); PG8_BAR; PG8_SCHED;
            PG8_LDB(B1, 0, 1); PG8_STAGE(PG8_SB(0, 0), b2, voffB);
            PG8_BAR; PG8_WAIT_L(0); PG8_MMA(0, 1, At, B1); PG8_BAR;
            PG8_LDA(At, 0, 1); PG8_STAGE(PG8_SA(0, 0), a2, voffA);
            PG8_BAR; PG8_WAIT_L(0); PG8_MMA(1, 0, At, B0); PG8_BAR; PG8_SCHED;
            PG8_STAGE(PG8_SB(0, 1), b2 + hstep, voffB);
            PG8_WAIT_V(6); PG8_BAR; PG8_MMA(1, 1, At, B1); PG8_BAR;
            PG8_LDB(B0, 1, 0); PG8_SCHED; PG8_LDA(At, 1, 0); PG8_STAGE(PG8_SA(0, 1), a2 + hstep, voffA);
            PG8_WAIT_L(8); PG8_BAR; PG8_WAIT_L(0); PG8_MMA(0, 0, At, B0); PG8_BAR; PG8_SCHED;
            PG8_LDB(B1, 1, 1); PG8_STAGE(PG8_SB(1, 0), b3, voffB);
            PG8_BAR; PG8_WAIT_L(0); PG8_MMA(0, 1, At, B1); PG8_BAR;
            PG8_LDA(At, 1, 1); PG8_STAGE(PG8_SA(1, 0), a3, voffA);
            PG8_BAR; PG8_WAIT_L(0); PG8_MMA(1, 0, At, B0); PG8_BAR; PG8_SCHED;
            PG8_STAGE(PG8_SB(1, 1), b3 + hstep, voffB);
            PG8_WAIT_V(6); PG8_BAR; PG8_MMA(1, 1, At, B1); PG8_BAR;
            }
        }
        if constexpr (ALIGN_EPI) { if (wr == 0) PG8_BAR; }
        if constexpr (!Epi::AFTER_DRAIN) { E(acc, cur, wr, wc, fr, fq); S.done(cur); }
        if (!has_next) break;
#pragma unroll
        for (int a = 0; a < 2; ++a)
#pragma unroll
            for (int b = 0; b < 2; ++b)
#pragma unroll
                for (int m = 0; m < 4; ++m)
#pragma unroll
                    for (int n = 0; n < 2; ++n) acc[a][b][m][n] = (f32x4){0.f, 0.f, 0.f, 0.f};
        cur = nxt; cA = nA; cB = nB; ++ui;
        if constexpr (ALIGN_EPI) { if (wr == 1) PG8_BAR; }
    }
    PG8_WAIT_V(0);
    if constexpr (!ALIGN_EPI) { if (wr == 0) PG8_BAR; }
    PG8_BAR;
    if constexpr (Epi::AFTER_DRAIN) { E.fused(acc, cur, wr, wc, fr, fq, lds, wid, lane); S.done(cur); }
#undef PG8_SA
#undef PG8_SB
#undef PG8_STAGE
#undef PG8_LDA
#undef PG8_LDB
#undef PG8_MMA
#undef PG8_WAIT_V
#undef PG8_WAIT_L
#undef PG8_BAR
#undef PG8_SCHED
}
}
#include <hip/hip_bf16.h>
#include <cmath>
namespace attn_body {
using bf16=__hip_bfloat16;
using bf16x8=__attribute__((ext_vector_type(8)))short;
using s16x4=__attribute__((ext_vector_type(4)))short;
using f32x16=__attribute__((ext_vector_type(16)))float;
using u32x4=__attribute__((ext_vector_type(4)))unsigned;
constexpr int BATCH=4,NHEAD=8,SEQ=8192,D=64,KVP=512,OP=1024;
constexpr int NW=8,QBLK=32,QB=QBLK*NW,KVBLK=64,NQB=SEQ/QB;
constexpr int ATTN_UNIT_ROWS=QB;
__device__ __forceinline__ int crow(int r,int hi){return (r&3)+8*(r>>2)+4*hi;}
#define SBAR() __builtin_amdgcn_sched_barrier(0)
__device__ __forceinline__ void cmask(f32x16&p0,f32x16&p1,int jb,int qrel,int hi){
  const float NEG=-INFINITY; int kb=64*jb+4*hi;
  #pragma unroll
  for(int r=0;r<16;++r){int kv=kb+(r&3)+8*(r>>2); if(kv>qrel)p0[r]=NEG; if(kv+32>qrel)p1[r]=NEG;}
}

constexpr int NSLOT=3, SLOTB=8192, SKIP_T=40;
constexpr int LDS_K=0, LDS_V=NSLOT*SLOTB, LDS_WS=2*NSLOT*SLOTB, LDS_OST=LDS_WS+NW*64*4, LDS_FB=LDS_OST+NW*4096, LDS_BYTES=LDS_FB+SEQ*4;
constexpr float C2=0.125f*1.4426950408889634f;
__device__ __forceinline__ void glds16(const void*gsrc,unsigned lds_dst){unsigned keep;
  asm volatile("s_mov_b32 %0, m0\n\ts_mov_b32 m0, %2\n\ts_nop 0\n\tglobal_load_lds_dwordx4 %1, off\n\ts_mov_b32 m0, %0":"=&s"(keep):"v"(gsrc),"s"(lds_dst):"memory");}
__device__ __forceinline__ float max3f(float a,float b,float c){float r;asm("v_max3_f32 %0, %1, %2, %3":"=v"(r):"v"(a),"v"(b),"v"(c));return r;}
__device__ __forceinline__ float max2f(float a,float b){float r;asm("v_max_f32_e32 %0, %1, %2":"=v"(r):"v"(a),"v"(b));return r;}
__device__ __forceinline__ float fadd_s(float a,float b){float r;asm("v_add_f32_e32 %0, %1, %2":"=v"(r):"v"(a),"v"(b));return r;}
__device__ __forceinline__ float fsub_s(float a,float b){float r;asm("v_sub_f32_e32 %0, %1, %2":"=v"(r):"v"(a),"v"(b));return r;}
typedef float f32x2_t __attribute__((ext_vector_type(2))); typedef __bf16 bf16x2_t __attribute__((ext_vector_type(2)));
__device__ __forceinline__ unsigned cvtpk_s(float lo,float hi){f32x2_t v={lo,hi};bf16x2_t b=__builtin_convertvector(v,bf16x2_t);return __builtin_bit_cast(unsigned,b);}
#define WAIT_BAR(N) asm volatile("s_waitcnt vmcnt(" #N ") lgkmcnt(0)\n\ts_barrier":::"memory")

__device__ __forceinline__ void qkt(f32x16&p0,f32x16&p1,const char*Kslot,const bf16x8*qr,int r32,int hi){
  const char*kb=Kslot+hi*1024+r32*16;
  #pragma unroll
  for(int d0=0;d0<4;++d0){
    const bf16x8 b0=*reinterpret_cast<const bf16x8*>(kb+d0*2048);
    const bf16x8 b1=*reinterpret_cast<const bf16x8*>(kb+d0*2048+512);
    p0=__builtin_amdgcn_mfma_f32_32x32x16_bf16(b0,qr[d0],p0,0,0,0);p1=__builtin_amdgcn_mfma_f32_32x32x16_bf16(b1,qr[d0],p1,0,0,0);}
}
typedef __attribute__((address_space(3))) const char* lds_cptr;
typedef __attribute__((address_space(3))) char* lds_cptr_nc;
typedef float f32x4_t __attribute__((ext_vector_type(4)));
typedef short v4i16_t __attribute__((ext_vector_type(4)));
__device__ __forceinline__ void kload8(bf16x8*kf,lds_cptr kp){
  kf[0]=*(const __attribute__((address_space(3))) bf16x8*)(kp);      kf[1]=*(const __attribute__((address_space(3))) bf16x8*)(kp+512);
  kf[2]=*(const __attribute__((address_space(3))) bf16x8*)(kp+2048); kf[3]=*(const __attribute__((address_space(3))) bf16x8*)(kp+2560);
  kf[4]=*(const __attribute__((address_space(3))) bf16x8*)(kp+4096); kf[5]=*(const __attribute__((address_space(3))) bf16x8*)(kp+4608);
  kf[6]=*(const __attribute__((address_space(3))) bf16x8*)(kp+6144); kf[7]=*(const __attribute__((address_space(3))) bf16x8*)(kp+6656);
}
__device__ __forceinline__ void kload2(bf16x8*kf,lds_cptr kp,int j){ kf[2*j]=*(const __attribute__((address_space(3))) bf16x8*)(kp+j*2048); kf[2*j+1]=*(const __attribute__((address_space(3))) bf16x8*)(kp+j*2048+512); }
__device__ __forceinline__ s16x4 vtr(lds_cptr p){ return __builtin_bit_cast(s16x4,__builtin_amdgcn_ds_read_tr16_b64_v4i16((__attribute__((address_space(3))) v4i16_t*)p)); }
__device__ __forceinline__ float rowmax(const f32x16&p0,const f32x16&p1){
  float a=max3f(p0[0],p0[1],p1[0]),b=max3f(p0[2],p0[3],p1[1]);a=max3f(a,p1[2],p1[3]);
  #pragma unroll
  for(int r=4;r<16;r+=4){a=max3f(a,p0[r],p0[r+1]);b=max3f(b,p0[r+2],p0[r+3]);a=max3f(a,p1[r],p1[r+1]);b=max3f(b,p1[r+2],p1[r+3]);}
  const float m=max2f(a,b);
  auto rr=__builtin_amdgcn_permlane32_swap(__float_as_uint(m),__float_as_uint(m),false,false);
  return max2f(__uint_as_float(rr[0]),__uint_as_float(rr[1]));
}
__device__ __forceinline__ void pv(f32x16*o,int vb,bf16x8 pa0,bf16x8 pa1,bf16x8 pa2,bf16x8 pa3){
  #pragma unroll
  for(int d0=0;d0<2;++d0){s16x4 lo[4],hi[4];
    #pragma unroll
    for(int ks=0;ks<4;++ks){
      asm volatile("ds_read_b64_tr_b16 %0,%1 offset:%c2":"=&v"(lo[ks]):"v"(vb),"i"(d0*4096+ks*1024):"memory");
      asm volatile("ds_read_b64_tr_b16 %0,%1 offset:%c2":"=&v"(hi[ks]):"v"(vb),"i"(d0*4096+ks*1024+512):"memory");}
    asm volatile("s_waitcnt lgkmcnt(0)":::"memory");SBAR();
    #define PK(k) (bf16x8){lo[k][0],lo[k][1],lo[k][2],lo[k][3],hi[k][0],hi[k][1],hi[k][2],hi[k][3]}
    o[d0]=__builtin_amdgcn_mfma_f32_32x32x16_bf16(pa0,PK(0),o[d0],0,0,0);
    o[d0]=__builtin_amdgcn_mfma_f32_32x32x16_bf16(pa1,PK(1),o[d0],0,0,0);
    o[d0]=__builtin_amdgcn_mfma_f32_32x32x16_bf16(pa2,PK(2),o[d0],0,0,0);
    o[d0]=__builtin_amdgcn_mfma_f32_32x32x16_bf16(pa3,PK(3),o[d0],0,0,0);
    #undef PK
  }
}

#ifndef ATTN_STORE16
#define ATTN_STORE16(p,v) (*(u32x4*)(p)=(v))
#endif
template<int THRL> __device__ __forceinline__ void attn_unit(int b,int h,int qb,const bf16*Q,const bf16*__restrict__ K,const bf16*__restrict__ V,const float*__restrict__ FB,const unsigned*__restrict__ KN2,bf16*O,float*SSQ,char*shm){
  const int tid=threadIdx.x,lane=tid&63,r32=lane&31,hi=lane>>5; const int wid=__builtin_amdgcn_readfirstlane(tid>>6);
  const long rowbase=(long)b*SEQ; const int q0=qb*QB;
  const bf16*Qw=Q+(rowbase+q0+wid*QBLK)*KVP+h*D;
  const bf16*Kh=K+rowbase*KVP+h*D,*Vh=V+rowbase*KVP+h*D;
  const unsigned lds0=(unsigned)(uintptr_t)shm;
  float*wsf=(float*)(shm+LDS_WS)+wid*64;
  const bf16*ksrc=Kh+(long)lane*KVP+wid*8;
  const bf16*vsrc=Vh+(long)(16*(wid&3)+(lane>>2))*KVP+(wid>>2)*32+(lane&3)*8;
  const unsigned kdst=lds0+LDS_K+wid*1024, vdst=lds0+LDS_V+wid*1024;
  #define DMA_K(t,slot) glds16(ksrc+(long)(NT-1-(t))*KVBLK*KVP,(unsigned)__builtin_amdgcn_readfirstlane(kdst+(slot)))
  #define DMA_V(t,slot) glds16(vsrc+(long)(NT-1-(t))*KVBLK*KVP,(unsigned)__builtin_amdgcn_readfirstlane(vdst+(slot)))
  const int vb0=(int)(lds0+LDS_V)+((lane>>4)&1)*32+(lane&3)*8+(4*hi+((lane&15)>>2))*64;
  const char*Kbase=shm+LDS_K; bf16x8 kf[8];
  const lds_cptr shm3=(lds_cptr)shm; const lds_cptr kp0=shm3+LDS_K+hi*1024+r32*16; const lds_cptr vp0=shm3+LDS_V+((lane>>4)&1)*32+(lane&3)*8+(4*hi+((lane&15)>>2))*64;
  const int NT=(q0+QB)/KVBLK;
  { const float*FBs=FB+(long)(b*NHEAD+h)*SEQ; typedef __attribute__((address_space(3))) f32x4_t* lds_f4p; const int nfb=q0+QB;
    int i0_=tid*4; asm volatile("":"+v"(i0_));
    for(int i=i0_;i<nfb;i+=NW*64*4){ const f32x4_t v=*(const f32x4_t*)(FBs+i); *(lds_f4p)((lds_cptr_nc)shm+LDS_FB+i*4)=v; } }
  const lds_cptr fbp0=(lds_cptr)shm+LDS_FB+hi*16;
  DMA_K(0,0);DMA_V(0,0);DMA_K(1,SLOTB);
  bf16x8 qr[4];
  #pragma unroll
  for(int d0=0;d0<4;++d0)qr[d0]=*reinterpret_cast<const bf16x8*>(&Qw[(long)r32*KVP+d0*16+hi*8]);
  const float*FBg=FB+(long)(b*NHEAD+h)*SEQ;
  float sd=0.f,qn=0.f;
  { const bf16*Kd=Kh+(long)(q0+wid*QBLK+r32)*KVP+hi*8;
    #pragma unroll
    for(int d0=0;d0<4;++d0){ const bf16x8 kv=*reinterpret_cast<const bf16x8*>(Kd+d0*16);
      #pragma unroll
      for(int j=0;j<8;++j){ const float qf=__uint_as_float((unsigned)(unsigned short)qr[d0][j]<<16), kf_=__uint_as_float((unsigned)(unsigned short)kv[j]<<16); sd+=qf*kf_; qn+=qf*qf; } }
    auto r1=__builtin_amdgcn_permlane32_swap(__float_as_uint(sd),__float_as_uint(sd),false,false); sd=__uint_as_float(r1[0])+__uint_as_float(r1[1]);
    auto r2=__builtin_amdgcn_permlane32_swap(__float_as_uint(qn),__float_as_uint(qn),false,false); qn=__uint_as_float(r2[0])+__uint_as_float(r2[1]); }
  float mhat=sd+FBg[q0+wid*QBLK+r32],l_reg=0.f;f32x16 o[2];o[0]=f32x16{};o[1]=f32x16{};
  { float smin=mhat,qmax=qn;
    #pragma unroll
    for(int o_=1;o_<32;o_<<=1){ smin=fminf(smin,__shfl_xor(smin,o_)); qmax=fmaxf(qmax,__shfl_xor(qmax,o_)); }
    if(lane==0){ __attribute__((address_space(3))) float*st_=(__attribute__((address_space(3))) float*)((lds_cptr_nc)shm+LDS_OST)+wid*2; st_[0]=smin; st_[1]=qmax; } }
  #define FBC(C0,C1,t) do{ const lds_cptr fp_=fbp0+(NT-1-(t))*256; _Pragma("unroll") for(int g_=0;g_<4;++g_){ \
      const f32x4_t a_=*(const __attribute__((address_space(3))) f32x4_t*)(fp_+g_*32), b_=*(const __attribute__((address_space(3))) f32x4_t*)(fp_+128+g_*32); \
      _Pragma("unroll") for(int j_=0;j_<4;++j_){ C0[4*g_+j_]=a_[j_]-mhat; C1[4*g_+j_]=b_[j_]-mhat; } } }while(0)
  const int qrel=wid*QBLK+r32;
  #define CMASK(P0,P1,t) do{int jb_=3-(t); if(jb_>=0)cmask(P0,P1,jb_,qrel,hi);}while(0)
  bool resc=false;
  #define START(P0,P1) do{ const float rm=rowmax(P0,P1); resc=false; \
    { const float dl=__builtin_fmaxf(rm,0.f); mhat=fadd_s(mhat,dl); \
      _Pragma("unroll") for(int r=0;r<16;++r){P0[r]=fsub_s(P0[r],dl);P1[r]=fsub_s(P1[r],dl);} } \
    _Pragma("unroll") for(int r=0;r<16;++r)P0[r]=__builtin_amdgcn_exp2f(P0[r]); }while(0)
  #define RESC() do{ if(resc){ asm volatile("s_waitcnt lgkmcnt(0)":::"memory"); \
      _Pragma("unroll") for(int d_=0;d_<2;++d_) _Pragma("unroll") for(int r=0;r<16;++r)o[d_][r]*=wsf[crow(r,hi)]; } }while(0)
  f32x16 pA0,pA1,pB0,pB1;
  int sl_prev=0,sl_cur=0,sl_next=SLOTB;
  #define ROT() do{sl_prev=sl_cur;sl_cur=sl_next;sl_next=(sl_next==(NSLOT-1)*SLOTB)?0:sl_next+SLOTB;}while(0)
  DMA_K(2,2*SLOTB);
  WAIT_BAR(3);
  int NS;
  { const __attribute__((address_space(3))) float*st_=(const __attribute__((address_space(3))) float*)((lds_cptr)shm+LDS_OST); float sm=st_[0],qm=st_[1];
    #pragma unroll
    for(int w=1;w<NW;++w){ sm=fminf(sm,st_[2*w]); qm=fmaxf(qm,st_[2*w+1]); }
    const float kn2=(__uint_as_float(__hip_atomic_load(KN2+(b*NHEAD+h)*2,__ATOMIC_RELAXED,__HIP_MEMORY_SCOPE_AGENT))+__uint_as_float(__hip_atomic_load(KN2+(b*NHEAD+h)*2+1,__ATOMIC_RELAXED,__HIP_MEMORY_SCOPE_AGENT)))*1.02f;
    const float bound=sm-(float)SKIP_T-sqrtf(qm*kn2)*1.001f;
    const int ncand=NT-4; const bool c0=(lane<ncand)&&(FBg[64*(lane<ncand?lane:0)+63]<=bound), c1=(lane+64<ncand)&&(FBg[64*(lane+64<ncand?lane+64:0)+63]<=bound);
    const int cnt=__builtin_popcountll(__ballot(c0))+__builtin_popcountll(__ballot(c1));
    NS=__builtin_amdgcn_readfirstlane(NT-(cnt&~1)); }
  FBC(pA0,pA1,0);
  qkt(pA0,pA1,Kbase,qr,r32,hi);asm volatile("s_nop 15\n\ts_nop 7":"+v"(pA0),"+v"(pA1));CMASK(pA0,pA1,0);
  START(pA0,pA1);
  _Pragma("unroll") for(int r=0;r<16;++r)pA1[r]=__builtin_amdgcn_exp2f(pA1[r]);
  FBC(pB0,pB1,1);
  WAIT_BAR(0);
  DMA_K(3,0);DMA_V(1,SLOTB);
  ROT();
  kload8(kf,kp0+sl_cur);
  WAIT_BAR(2);
  s16x4 vlo[8],vhi[8]; u32x4 pw0,pw1,pw2,pw3;
  #define PKW(P,B) cvtpk_s(P[B],P[B+1])
  #define PAF(k) __builtin_bit_cast(bf16x8,pw##k)
  #define VFR(i) (bf16x8){vlo[i][0],vlo[i][1],vlo[i][2],vlo[i][3],vhi[i][0],vhi[i][1],vhi[i][2],vhi[i][3]}
  #define PIN(x) asm volatile("":"+v"(x))
  #define MX3(a,b,c) __builtin_fmaxf(__builtin_fmaxf((a),(b)),(c))
  #define GAPA(MF,A0,A1,A2,A3,W0,W1,PW) do{ MF; sacc+=A0; sacc+=A1; sacc+=A2; sacc+=A3; PIN(sacc); W0; W1; PIN(PW); SBAR(); }while(0)
  #define EX(v) __builtin_amdgcn_exp2f(v)
  #define GAPB(MF,X,B) do{ MF; X[B]=EX(X[B]); X[B+1]=EX(X[B+1]); X[B+2]=EX(X[B+2]); X[B+3]=EX(X[B+3]); PIN(X); SBAR(); }while(0)
  #define VRD(i) do{ vlo[i]=vtr(vp_+(((i)>>2)*4096+((i)&3)*1024)); vhi[i]=vtr(vp_+(((i)>>2)*4096+((i)&3)*1024+512)); }while(0)
  #define KRD(G,j) do{ if(G){ kload2(kf,kp0+sl_next,j); SBAR(); } }while(0)
  #define STEP(C0,C1,P0,P1,t,GK,GV,GL,GN) do{ SBAR(); \
    const lds_cptr vp_=vp0+sl_prev; \
    VRD(0); SBAR(); float sacc=(P0[0]+P0[1]); \
    GAPA(C0=__builtin_amdgcn_mfma_f32_32x32x16_bf16(kf[0],qr[0],C0,0,0,0), P0[2],P0[3],P0[4],P0[5],     pw0[0]=PKW(P0,0), pw0[1]=PKW(P0,2), pw0); \
    VRD(4); SBAR(); GAPA(C1=__builtin_amdgcn_mfma_f32_32x32x16_bf16(kf[1],qr[0],C1,0,0,0), P0[6],P0[7],P0[8],P0[9],     pw0[2]=PKW(P0,4), pw0[3]=PKW(P0,6), pw0); \
    VRD(1); SBAR(); GAPA(C0=__builtin_amdgcn_mfma_f32_32x32x16_bf16(kf[2],qr[1],C0,0,0,0),   P0[10],P0[11],P0[12],P0[13], pw1[0]=PKW(P0,8), pw1[1]=PKW(P0,10), pw1); \
    VRD(5); SBAR(); GAPA(C1=__builtin_amdgcn_mfma_f32_32x32x16_bf16(kf[3],qr[1],C1,0,0,0),   P0[14],P0[15],P1[0],P1[1],   pw1[2]=PKW(P0,12),pw1[3]=PKW(P0,14), pw1); \
    VRD(2); SBAR(); GAPA(C0=__builtin_amdgcn_mfma_f32_32x32x16_bf16(kf[4],qr[2],C0,0,0,0),   P1[2],P1[3],P1[4],P1[5],     pw2[0]=PKW(P1,0), pw2[1]=PKW(P1,2), pw2); \
    VRD(6); SBAR(); GAPA(C1=__builtin_amdgcn_mfma_f32_32x32x16_bf16(kf[5],qr[2],C1,0,0,0),   P1[6],P1[7],P1[8],P1[9],     pw2[2]=PKW(P1,4), pw2[3]=PKW(P1,6), pw2); \
    VRD(3); SBAR(); GAPA(C0=__builtin_amdgcn_mfma_f32_32x32x16_bf16(kf[6],qr[3],C0,0,0,0),   P1[10],P1[11],P1[12],P1[13], pw3[0]=PKW(P1,8), pw3[1]=PKW(P1,10), pw3); \
    VRD(7); SBAR(); GAPA(C1=__builtin_amdgcn_mfma_f32_32x32x16_bf16(kf[7],qr[3],C1,0,0,0),   P1[14],P1[15],0.f,0.f,       pw3[2]=PKW(P1,12),pw3[3]=PKW(P1,14), pw3); \
    l_reg+=sacc; \
    if(GK){DMA_K((t)+3,sl_cur);} if(GV){DMA_V((t)+1,sl_next);} \
    CMASK(C0,C1,t); \
    { float a=MX3(C0[0],C0[1],C1[0]),b=MX3(C0[2],C0[3],C1[1]); a=MX3(a,C1[2],C1[3]); \
      _Pragma("unroll") for(int r=4;r<16;r+=4){a=MX3(a,C0[r],C0[r+1]);b=MX3(b,C0[r+2],C0[r+3]);a=MX3(a,C1[r],C1[r+1]);b=MX3(b,C1[r+2],C1[r+3]);} \
      float rm=__builtin_fmaxf(a,b); { auto rr=__builtin_amdgcn_permlane32_swap(__float_as_uint(rm),__float_as_uint(rm),false,false); rm=__builtin_fmaxf(__uint_as_float(rr[0]),__uint_as_float(rr[1])); } \
      resc=false; \
      if(__builtin_expect(__any(rm>(float)THRL),0)){ const float dl=__builtin_fmaxf(rm,0.f); mhat+=dl; \
        _Pragma("unroll") for(int r=0;r<16;++r){C0[r]-=dl;C1[r]-=dl;} \
        const float f=__builtin_amdgcn_exp2f(-dl); l_reg*=f; if(hi==0)wsf[r32]=f; resc=true; } } \
    SBAR(); \
    GAPB(o[0]=__builtin_amdgcn_mfma_f32_32x32x16_bf16(PAF(0),VFR(0),o[0],0,0,0), C0,0); \
    GAPB(o[1]=__builtin_amdgcn_mfma_f32_32x32x16_bf16(PAF(0),VFR(4),o[1],0,0,0), C0,4); \
    KRD(GL,0); GAPB(o[0]=__builtin_amdgcn_mfma_f32_32x32x16_bf16(PAF(1),VFR(1),o[0],0,0,0), C0,8); \
    KRD(GL,1); GAPB(o[1]=__builtin_amdgcn_mfma_f32_32x32x16_bf16(PAF(1),VFR(5),o[1],0,0,0), C0,12); \
    KRD(GL,2); GAPB(o[0]=__builtin_amdgcn_mfma_f32_32x32x16_bf16(PAF(2),VFR(2),o[0],0,0,0), C1,0); \
    KRD(GL,3); GAPB(o[1]=__builtin_amdgcn_mfma_f32_32x32x16_bf16(PAF(2),VFR(6),o[1],0,0,0), C1,4); \
    GAPB(o[0]=__builtin_amdgcn_mfma_f32_32x32x16_bf16(PAF(3),VFR(3),o[0],0,0,0), C1,8); \
    GAPB(o[1]=__builtin_amdgcn_mfma_f32_32x32x16_bf16(PAF(3),VFR(7),o[1],0,0,0), C1,12); \
    if(GN){ FBC(P0,P1,(t)+1); } \
    }while(0)
  int t=1;
  #define ENDW(tt) do{ if((tt)+3<NS){WAIT_BAR(2);} else if((tt)+2<NS){WAIT_BAR(1);} else {WAIT_BAR(0);} }while(0)
  for(int pass=0;pass<2;++pass){
    for(;t+1<NS&&(pass==1||t<5);t+=2){
      STEP(pB0,pB1,pA0,pA1,t,(t+3<NS),(t+1<NS),(t+1<NS),(t+1<NS));       ENDW(t);   RESC(); ROT();
      STEP(pA0,pA1,pB0,pB1,t+1,(t+4<NS),(t+2<NS),(t+2<NS),(t+2<NS));     ENDW(t+1); RESC(); ROT();
    }
    if(pass==0){
  #undef CMASK
  #define CMASK(P0,P1,t) do{}while(0)
      for(;t+5<NS;t+=2){
        STEP(pB0,pB1,pA0,pA1,t,true,true,true,true);     WAIT_BAR(2); RESC(); ROT();
        STEP(pA0,pA1,pB0,pB1,t+1,true,true,true,true);   WAIT_BAR(2); RESC(); ROT();
      }
  #undef CMASK
  #define CMASK(P0,P1,t) do{int jb_=3-(t); if(jb_>=0)cmask(P0,P1,jb_,qrel,hi);}while(0)
    }
  }
  STEP(pB0,pB1,pA0,pA1,NS-1,false,false,false,false); RESC();
  { float sacc=pB0[0]+pB0[1]; _Pragma("unroll") for(int r=2;r<16;++r)sacc+=pB0[r]; _Pragma("unroll") for(int r=0;r<16;++r)sacc+=pB1[r]; l_reg+=sacc;
    pw0=(u32x4){PKW(pB0,0),PKW(pB0,2),PKW(pB0,4),PKW(pB0,6)};pw1=(u32x4){PKW(pB0,8),PKW(pB0,10),PKW(pB0,12),PKW(pB0,14)};pw2=(u32x4){PKW(pB1,0),PKW(pB1,2),PKW(pB1,4),PKW(pB1,6)};pw3=(u32x4){PKW(pB1,8),PKW(pB1,10),PKW(pB1,12),PKW(pB1,14)};
    SBAR(); pv(o,vb0+sl_cur,PAF(0),PAF(1),PAF(2),PAF(3)); }
  #undef PKW
  #undef PAF
  #undef VFR
  #undef PIN
  #undef MX3
  #undef GAPA
  #undef GAPB
  #undef EX
  #undef VRD
  #undef KRD
  #undef STEP
  #undef ENDW
  {auto rr=__builtin_amdgcn_permlane32_swap(__float_as_uint(l_reg),__float_as_uint(l_reg),false,false);l_reg=__uint_as_float(rr[0])+__uint_as_float(rr[1]);}
  if(hi==0)wsf[32+r32]=l_reg;asm volatile("s_waitcnt lgkmcnt(0)":::"memory");
  float rli[16];
  #pragma unroll
  for(int r=0;r<16;++r)rli[r]=__builtin_amdgcn_rcpf(wsf[32+crow(r,hi)]);
  bf16*Ow=O+(rowbase+q0+wid*QBLK)*OP+h*D; float*Sw=SSQ+(rowbase+q0+wid*QBLK)*NHEAD+h;
  { bf16*stg=(bf16*)(shm+LDS_OST)+wid*2048;
    #pragma unroll
    for(int r=0;r<16;++r){const int orow=crow(r,hi);
      #pragma unroll
      for(int d0=0;d0<2;++d0)stg[orow*64+d0*32+r32]=__float2bfloat16(o[d0][r]*rli[r]);}
    asm volatile("s_waitcnt lgkmcnt(0)":::"memory");
    #pragma unroll
    for(int i=0;i<4;++i){const int row=i*8+(lane>>3),ch=lane&7; const u32x4 v=*(const u32x4*)(stg+row*64+ch*8); ATTN_STORE16(Ow+(long)row*OP+ch*8,v);
      float ss=0.f;
      #pragma unroll
      for(int q=0;q<4;++q){const float lo_=__uint_as_float(v[q]<<16),hi_=__uint_as_float(v[q]&0xffff0000u); ss+=lo_*lo_+hi_*hi_;}
      ss+=__shfl_xor(ss,1);ss+=__shfl_xor(ss,2);ss+=__shfl_xor(ss,4); if(ch==0)Sw[(long)row*NHEAD]=ss;} }
  asm volatile("s_waitcnt lgkmcnt(0)\n\ts_barrier":::"memory");
  #undef DMA_K
  #undef DMA_V
  #undef CMASK
  #undef START
  #undef RESC
  #undef ROT
  #undef FBC
}
constexpr int ATTN_LDS_BYTES=LDS_BYTES;
struct AttnTensors { const bf16* Q; const bf16* K; const bf16* V; const float* FB; const unsigned* KN2; bf16* O; float* SSQ; };
struct AttnUnit { int bh; int qb; };
struct StaticOrder {
  int vcu;
  __device__ __forceinline__ explicit StaticOrder(int grid,int block):vcu((block%8)*(grid/8)+block/8){}
  __device__ __forceinline__ bool next(int i,AttnUnit&u)const{ if(i>=4)return false; const int s=vcu&7; u.bh=vcu>>3; u.qb=(i==0)?s:(i==1)?15-s:(i==2)?16+s:31-s; return true; }
  __device__ __forceinline__ void a_ready(const AttnUnit&)const{}
  __device__ __forceinline__ void done(const AttnUnit&)const{}
};
template<class Sched,int THRL=8> __device__ __forceinline__ void attn_phase(char*lds,const AttnTensors&T,const Sched&S){
  AttnUnit u;
  for(int i=0;S.next(i,u);++i){ S.a_ready(u); attn_unit<THRL>(u.bh/NHEAD,u.bh%NHEAD,u.qb,T.Q,T.K,T.V,T.FB,T.KN2,T.O,T.SSQ,lds); S.done(u); }
}
#undef SBAR
#undef WAIT_BAR
}
#define GAS __attribute__((address_space(1)))
#define LAS __attribute__((address_space(3)))
typedef unsigned short bf16;
typedef unsigned v4u __attribute__((ext_vector_type(4)));
typedef float f32x4 __attribute__((ext_vector_type(4)));
typedef short bf16x8 __attribute__((ext_vector_type(8)));
typedef GAS unsigned gu32;
typedef GAS unsigned long long gu64;
#define RLX_AGENT __ATOMIC_RELAXED, __HIP_MEMORY_SCOPE_AGENT
#define LDS_WAIT() asm volatile("s_waitcnt lgkmcnt(0)" ::: "memory")
#define VM_WAIT() asm volatile("s_waitcnt vmcnt(0)" ::: "memory")
__device__ __forceinline__ unsigned long long rt() { return __builtin_amdgcn_s_memrealtime(); }
__device__ __forceinline__ unsigned f2bf(float f) { unsigned u = __builtin_bit_cast(unsigned, f); return (u + 0x7fffu + ((u >> 16) & 1u)) >> 16; }
__device__ __forceinline__ unsigned pk2(float lo, float hi) { return f2bf(lo) | (f2bf(hi) << 16); }

#define XB_TMO      128
#define XB_XCNT(j)  (256  + 64 * (j))
#define XB_XSUB(j)  (1280 + 64 * (j))
#define XB_XGEN(j)  (2304 + 64 * (j))
#define XB_TOP      3328
#define XB_TOPGEN   3392
#define XCD_BAR_WORDS 3456
#define XB_SPIN_CAP (1u << 18)

__device__ __forceinline__ unsigned xb_ld(unsigned* p)              { return __hip_atomic_load(p, __ATOMIC_RELAXED, __HIP_MEMORY_SCOPE_AGENT); }
__device__ __forceinline__ unsigned xb_add(unsigned* p, unsigned v) { return __hip_atomic_fetch_add(p, v, __ATOMIC_RELAXED, __HIP_MEMORY_SCOPE_AGENT); }
__device__ __forceinline__ unsigned xb_xcc_id() { return (unsigned)__builtin_amdgcn_s_getreg((3 << 11) | 20) & 0xFu; }
#define XB_SPIN(cond, bar) do { unsigned _sp = 0; while (cond) { __builtin_amdgcn_s_sleep(1); \
    if ((++_sp & 255u) == 0u) { if (xb_ld(&(bar)[XB_TMO])) break; if (_sp > XB_SPIN_CAP) { atomicAdd(&(bar)[XB_TMO], 1u); break; } } } } while (0)

struct XcdBarrier {
    unsigned* bar; unsigned x;
    volatile LAS unsigned* st;
};

__device__ __forceinline__ XcdBarrier xcd_barrier_post(unsigned* bar, volatile LAS unsigned* st) {
    XcdBarrier b; b.bar = bar; b.x = xb_xcc_id(); b.st = st;
    if (threadIdx.x == 0) (void)xb_add(&bar[XB_XCNT(b.x)], 1u);
    return b;
}
__device__ __forceinline__ void xcd_barrier_complete(unsigned* bar, unsigned x, unsigned& nloc, unsigned& nx) {
    const unsigned G = gridDim.x * gridDim.y * gridDim.z;
    unsigned sum, cnt, mine, sp = 0u;
    for (;;) {
        sum = 0u; cnt = 0u; mine = 0u;
#pragma unroll
        for (unsigned j = 0; j < 16; ++j) { const unsigned c = xb_ld(&bar[XB_XCNT(j)]); sum += c; cnt += (c > 0u) ? 1u : 0u; mine = (j == x) ? c : mine; }
        if (sum == G) break;
        __builtin_amdgcn_s_sleep(1);
        if ((++sp & 255u) == 0u) { if (xb_ld(&bar[XB_TMO])) break; if (sp > XB_SPIN_CAP) { atomicAdd(&bar[XB_TMO], 1u); break; } }
    }
    nloc = mine > 0u ? mine : 1u; nx = cnt > 0u ? cnt : 1u;
}

__device__ __forceinline__ void xcd_barrier(const XcdBarrier& b) {
    asm volatile("s_waitcnt vmcnt(0)" ::: "memory");
    __syncthreads();
    if (threadIdx.x == 0) {
        unsigned* bar = b.bar;
        __builtin_amdgcn_s_waitcnt(0);
        unsigned nloc = b.st[0], nx = b.st[1];
        if (nloc == 0u) { xcd_barrier_complete(bar, b.x, nloc, nx); b.st[0] = nloc; b.st[1] = nx; }
        const unsigned old = xb_add(&bar[XB_XSUB(b.x)], 1u);
        const unsigned gen = old / nloc;
        if (old + 1u == (gen + 1u) * nloc) {
            __builtin_amdgcn_fence(__ATOMIC_RELEASE, "agent");
            asm volatile("s_waitcnt vmcnt(0)" ::: "memory");
            const unsigned og = xb_add(&bar[XB_TOP], 1u);
            const unsigned tg = og / nx;
            if (og + 1u == (tg + 1u) * nx) xb_add(&bar[XB_TOPGEN], 1u);
            else XB_SPIN(xb_ld(&bar[XB_TOPGEN]) == tg, bar);
            __builtin_amdgcn_fence(__ATOMIC_ACQUIRE, "agent");
            xb_add(&bar[XB_XGEN(b.x)], 1u);
            asm volatile("s_waitcnt vmcnt(0)" ::: "memory");
        } else {
            XB_SPIN(xb_ld(&bar[XB_XGEN(b.x)]) == gen, bar);
            __builtin_amdgcn_fence(__ATOMIC_ACQUIRE, "agent");
            asm volatile("s_waitcnt vmcnt(0)" ::: "memory");
        }
    }
    __syncthreads();
}

constexpr int NWAVES = 8;
constexpr int RING_OFF = 0, RING_BYTES = 131072;
constexpr int LDSCTL_OFF = RING_BYTES, MISC_OFF = LDSCTL_OFF + 320;
constexpr int LDS_BYTES = 147456;
static_assert(MISC_OFF + 128 <= LDS_BYTES && attn_body::ATTN_LDS_BYTES <= RING_BYTES, "LDS map");

struct Args { const float* in[13]; float* out; unsigned char* ws; int ph_lo, ph_hi, li, pad; };

struct Ctx {
    LAS unsigned char* lds;
    int tid, lane, wave, vcu, G;
    const float *x, *g_mix, *w_in, *b_f, *w_conv, *g_conv_out, *g_attn_out, *w_o, *g_ffn, *w_up, *w_ffn_conv, *w_down, *g_final;
    float* out; unsigned char* ws;
};

__device__ __forceinline__ float wave_sum(float v) {
#pragma unroll
    for (int o = 1; o < 64; o <<= 1) v += __shfl_xor(v, o);
    return v;
}
__device__ __forceinline__ float bflo(unsigned w) { return __uint_as_float(w << 16); }
__device__ __forceinline__ float bfhi(unsigned w) { return __uint_as_float(w & 0xffff0000u); }
__device__ __forceinline__ float log_sigmoid_f(float v) { return v < 0.f ? v - log1pf(expf(v)) : -log1pf(expf(-v)); }

__device__ __forceinline__ void p0_tr_item(const float* W, int ldw, int k0, int nsrc0, bf16* WT, int ldt, int ndst0, int kd0, const float* kscale, LAS float* scr, int lane) {
#pragma unroll 8
    for (int i = 0; i < 32; ++i) { const int kk = 2 * i + (lane >> 5); float v = W[(size_t)(k0 + kk) * ldw + nsrc0 + (lane & 31)]; if (kscale) v *= kscale[kk]; scr[kk * 33 + (lane & 31)] = v; }
    LDS_WAIT(); asm volatile("" ::: "memory");
    const int c = lane & 7;
#pragma unroll
    for (int j = 0; j < 4; ++j) { const int n = (lane >> 3) + 8 * j; const LAS float* s = scr + (8 * c) * 33 + n;
        v4u o; o.x = pk2(s[0 * 33], s[1 * 33]); o.y = pk2(s[2 * 33], s[3 * 33]); o.z = pk2(s[4 * 33], s[5 * 33]); o.w = pk2(s[6 * 33], s[7 * 33]);
        *(v4u*)(WT + (size_t)(ndst0 + n) * ldt + kd0 + 8 * c) = o; }
    LDS_WAIT(); asm volatile("" ::: "memory");
}

__device__ __forceinline__ void p0_prologue(Ctx& F) {
    LAS float* scr = (LAS float*)(F.lds + RING_OFF + F.wave * 16384);
    const int gw = F.vcu * NWAVES + F.wave, NGW = F.G * NWAVES;
    bf16* WIN = (bf16*)(F.ws + WS_WIN); bf16* WO = (bf16*)(F.ws + WS_WO); bf16* WUP = (bf16*)(F.ws + WS_WUP); bf16* WDN = (bf16*)(F.ws + WS_WDN);
    constexpr int I_IN = 16 * 96, I_O = 16 * 32, I_UP = 16 * 176, I_DN = 44 * 32, NITEMS = I_IN + I_O + I_UP + I_DN;
    for (int it = gw; it < NITEMS; it += NGW) {
        int r = it;
        if (r < I_IN) { const int kb = r / 96, nb = r % 96, a = nb >> 4, j0 = (nb & 15) * 32;
            const int sb = (a == 0) ? 1536 : (a == 1) ? 2048 : (a == 2) ? 2560 : (a == 3) ? 0 : (a == 4) ? 512 : 1024;
            p0_tr_item(F.w_in, IN_COLS, 64 * kb, sb + j0, WIN, DMODEL, 32 * nb, 64 * kb, nullptr, scr, F.lane); continue; }
        r -= I_IN;
        if (r < I_O) { const int kb = r / 32, nb = r % 32, k0 = 64 * kb;
            p0_tr_item(F.w_o, DMODEL, k0, 32 * nb, WO, DMODEL, 32 * nb, (k0 + 512) & 1023, k0 >= 512 ? F.g_attn_out + (k0 - 512) : nullptr, scr, F.lane); continue; }
        r -= I_O;
        if (r < I_UP) { const int kb = r / 176, nb = r % 176, nd = 32 * nb, pn = nd >> 8, bj = (nd >> 7) & 1, j0 = nd & 127;
            p0_tr_item(F.w_up, 2 * DFF, 64 * kb, bj * DFF + 128 * pn + j0, WUP, DMODEL, nd, 64 * kb, F.g_ffn + 64 * kb, scr, F.lane); continue; }
        r -= I_UP;
        { const int kb = r / 32, nb = r % 32; p0_tr_item(F.w_down, DMODEL, 64 * kb, 32 * nb, WDN, DFF, 32 * nb, 64 * kb, nullptr, scr, F.lane); }
    }
    __syncthreads();
    LAS float* wf = (LAS float*)(F.lds + RING_OFF);
    for (int i = F.tid; i < 8 * DMODEL; i += NWAVES * 64) { const int k = i >> 3, hh = i & 7; wf[hh * DMODEL + k] = F.w_in[(size_t)k * IN_COLS + NMAIN + hh]; }
    LDS_WAIT(); __syncthreads();
    bf16* H1 = (bf16*)(F.ws + WS_H1); float* LOGF = (float*)(F.ws + WS_LOGF);
    f32x4 gm[4];
#pragma unroll
    for (int j = 0; j < 4; ++j) gm[j] = ((const f32x4*)F.g_mix)[F.lane + 64 * j];
    const float bfv = F.b_f[F.lane & 7];
    for (int m = gw; m < TOK; m += NGW) {
        const f32x4* xr = (const f32x4*)(F.x + (size_t)m * DMODEL) + F.lane;
        f32x4 v[4]; float s = 0.f;
#pragma unroll
        for (int j = 0; j < 4; ++j) { v[j] = xr[64 * j]; s += (v[j].x * v[j].x + v[j].y * v[j].y) + (v[j].z * v[j].z + v[j].w * v[j].w); }
        const float rstd = 1.0f / sqrtf(wave_sum(s) * (1.0f / DMODEL) + RMS_EPS);
        unsigned long long* o8 = (unsigned long long*)(H1 + (size_t)m * DMODEL) + F.lane;
#pragma unroll
        for (int j = 0; j < 4; ++j) { v[j] = v[j] * rstd * gm[j]; o8[64 * j] = (unsigned long long)pk2(v[j].x, v[j].y) | ((unsigned long long)pk2(v[j].z, v[j].w) << 32); }
        float mine = 0.f;
#pragma unroll
        for (int hh = 0; hh < 8; ++hh) { float p = 0.f;
#pragma unroll
            for (int j = 0; j < 4; ++j) { const f32x4 w = *(const LAS f32x4*)(wf + hh * DMODEL + 256 * j + 4 * F.lane); p += (v[j].x * w.x + v[j].y * w.y) + (v[j].z * w.z + v[j].w * w.w); }
            p = wave_sum(p); if (F.lane == hh) mine = p; }
        if (F.lane < 8) LOGF[(size_t)((m / SEQ) * NHEADS + F.lane) * SEQ + (m % SEQ)] = log_sigmoid_f(mine + bfv);
    }
}

__device__ __forceinline__ void p1_scan(Ctx& F, int bh) {
    const float* lf = (const float*)(F.ws + WS_LOGF) + (size_t)bh * SEQ; float* fb = (float*)(F.ws + WS_FB) + (size_t)bh * SEQ;
    LAS float* wt = (LAS float*)(F.lds + RING_OFF);
    float e[16];
#pragma unroll
    for (int j = 0; j < 4; ++j) { const f32x4 t = ((const f32x4*)lf)[F.tid * 4 + j]; e[4 * j] = t.x; e[4 * j + 1] = t.y; e[4 * j + 2] = t.z; e[4 * j + 3] = t.w; }
#pragma unroll
    for (int j = 1; j < 16; ++j) e[j] += e[j - 1];
    float incl = e[15];
#pragma unroll
    for (int o = 1; o < 64; o <<= 1) { const float t = __shfl_up(incl, o); if (F.lane >= o) incl += t; }
    if (F.lane == 63) wt[F.wave] = incl;
    LDS_WAIT(); __syncthreads();
    float base = incl - e[15];
    for (int w = 0; w < F.wave; ++w) base += wt[w];
#pragma unroll
    for (int j = 0; j < 4; ++j) { f32x4 t; t.x = -LOG2E * (base + e[4 * j]); t.y = -LOG2E * (base + e[4 * j + 1]); t.z = -LOG2E * (base + e[4 * j + 2]); t.w = -LOG2E * (base + e[4 * j + 3]); ((f32x4*)fb)[F.tid * 4 + j] = t; }
    __syncthreads();
}

__device__ __forceinline__ void unpack8(const v4u w, float (&f)[8]) { f[0] = bflo(w.x); f[1] = bfhi(w.x); f[2] = bflo(w.y); f[3] = bfhi(w.y); f[4] = bflo(w.z); f[5] = bfhi(w.z); f[6] = bflo(w.w); f[7] = bfhi(w.w); }
__device__ __forceinline__ void p2_conv(Ctx& F) {
    const int gw = F.vcu * NWAVES + F.wave, NGW = F.G * NWAVES, c0 = 8 * F.lane;
    const bf16* GB = (const bf16*)(F.ws + WS_QKV + 3 * QKV_STRIDE); const bf16* GC = (const bf16*)(F.ws + WS_QKV + 4 * QKV_STRIDE); const bf16* XC = (const bf16*)(F.ws + WS_QKV + 5 * QKV_STRIDE);
    bf16* MIX = (bf16*)(F.ws + WS_MIX);
    float w0[8], w1[8], w2[8], gco[8];
#pragma unroll
    for (int j = 0; j < 8; ++j) { w0[j] = F.w_conv[c0 + j]; w1[j] = F.w_conv[CONV_CH + c0 + j]; w2[j] = F.w_conv[2 * CONV_CH + c0 + j]; gco[j] = F.g_conv_out[c0 + j]; }
    for (int run = gw; run < TOK / 16; run += NGW) {
        const int t0 = run * 16; float p2[8], p1[8];
        if ((t0 % SEQ) == 0) {
#pragma unroll
            for (int j = 0; j < 8; ++j) { p2[j] = 0.f; p1[j] = 0.f; }
        } else { float a[8], b[8];
            unpack8(*(const v4u*)(GC + (size_t)(t0 - 2) * CONV_CH + c0), a); unpack8(*(const v4u*)(XC + (size_t)(t0 - 2) * CONV_CH + c0), b);
#pragma unroll
            for (int j = 0; j < 8; ++j) p2[j] = a[j] * b[j];
            unpack8(*(const v4u*)(GC + (size_t)(t0 - 1) * CONV_CH + c0), a); unpack8(*(const v4u*)(XC + (size_t)(t0 - 1) * CONV_CH + c0), b);
#pragma unroll
            for (int j = 0; j < 8; ++j) p1[j] = a[j] * b[j]; }
        for (int i = 0; i < 16; ++i) { const size_t t = (size_t)(t0 + i); float gb[8], a[8], b[8], y[8]; float ss = 0.f;
            unpack8(*(const v4u*)(GB + t * CONV_CH + c0), gb); unpack8(*(const v4u*)(GC + t * CONV_CH + c0), a); unpack8(*(const v4u*)(XC + t * CONV_CH + c0), b);
#pragma unroll
            for (int j = 0; j < 8; ++j) { const float p = a[j] * b[j]; y[j] = gb[j] * (w0[j] * p2[j] + w1[j] * p1[j] + w2[j] * p); p2[j] = p1[j]; p1[j] = p; ss += y[j] * y[j]; }
            const float rstd = 1.0f / sqrtf(wave_sum(ss) * (1.0f / CONV_CH) + RMS_EPS);
            v4u o; o.x = pk2(y[0] * rstd * gco[0], y[1] * rstd * gco[1]); o.y = pk2(y[2] * rstd * gco[2], y[3] * rstd * gco[3]); o.z = pk2(y[4] * rstd * gco[4], y[5] * rstd * gco[5]); o.w = pk2(y[6] * rstd * gco[6], y[7] * rstd * gco[7]);
            *(v4u*)(MIX + t * DMODEL + CONV_CH + c0) = o; }
    }
}

__device__ __forceinline__ void p4_fixup(Ctx& F) {
    const float* HF = (const float*)(F.ws + WS_HF); const float* HL = (const float*)(F.ws + WS_HL); bf16* ACT = (bf16*)(F.ws + WS_ACT);
    constexpr int NCG = DFF / 8, NIT = 512 * 2 * NCG;
    for (int it = F.vcu * (NWAVES * 64) + F.tid; it < NIT; it += F.G * NWAVES * 64) {
        const int blk = it / (2 * NCG), rem = it % (2 * NCG), rr = rem / NCG, ch0 = 8 * (rem % NCG);
        const bool first = (blk % (SEQ / 64)) == 0;
        float u[2][8];
#pragma unroll
        for (int bj = 0; bj < 2; ++bj) {
            const float* c_ = HF + ((size_t)(blk * 2 + rr) * 2 + bj) * DFF + ch0;
            const float* p1_ = (rr == 1) ? HF + ((size_t)(blk * 2 + 0) * 2 + bj) * DFF + ch0 : HL + ((size_t)((blk - 1) * 2 + 1) * 2 + bj) * DFF + ch0;
            const float* p2_ = (rr == 1) ? HL + ((size_t)((blk - 1) * 2 + 1) * 2 + bj) * DFF + ch0 : HL + ((size_t)((blk - 1) * 2 + 0) * 2 + bj) * DFF + ch0;
            const bool z1 = first && rr == 0, z2 = first;
#pragma unroll
            for (int q = 0; q < 2; ++q) {
                const f32x4 cur = *(const f32x4*)(c_ + 4 * q);
                const f32x4 a1 = z1 ? (f32x4){0.f, 0.f, 0.f, 0.f} : *(const f32x4*)(p1_ + 4 * q);
                const f32x4 a2 = z2 ? (f32x4){0.f, 0.f, 0.f, 0.f} : *(const f32x4*)(p2_ + 4 * q);
                const f32x4 w0 = *(const f32x4*)(F.w_ffn_conv + bj * DFF + ch0 + 4 * q), w1 = *(const f32x4*)(F.w_ffn_conv + 2 * DFF + bj * DFF + ch0 + 4 * q), w2 = *(const f32x4*)(F.w_ffn_conv + 4 * DFF + bj * DFF + ch0 + 4 * q);
                const f32x4 r = w2 * cur + w1 * a1 + w0 * a2;
                u[bj][4 * q] = r.x; u[bj][4 * q + 1] = r.y; u[bj][4 * q + 2] = r.z; u[bj][4 * q + 3] = r.w; }
        }
        float o[8];
#pragma unroll
        for (int j = 0; j < 8; ++j) { const float a = u[0][j], g = u[1][j]; o[j] = a * g * __builtin_amdgcn_rcpf(1.0f + __builtin_amdgcn_exp2f(-g * LOG2E)); }
        v4u pk; pk.x = pk2(o[0], o[1]); pk.y = pk2(o[2], o[3]); pk.z = pk2(o[4], o[5]); pk.w = pk2(o[6], o[7]);
        *(v4u*)(ACT + (size_t)(blk * 64 + rr) * DFF + ch0) = pk;
    }
}

__device__ __forceinline__ void p6_final(Ctx& F) {
    const int gw = F.vcu * NWAVES + F.wave, NGW = F.G * NWAVES; const float* SSQ2 = (const float*)(F.ws + WS_SSQ2);
    f32x4 gf[4];
#pragma unroll
    for (int j = 0; j < 4; ++j) gf[j] = ((const f32x4*)F.g_final)[F.lane + 64 * j];
    for (int m = gw; m < TOK; m += NGW) {
        f32x4* xr = (f32x4*)(F.out + (size_t)m * DMODEL) + F.lane; const f32x4* sp = (const f32x4*)(SSQ2 + (size_t)m * 16);
        const f32x4 a = sp[0], b = sp[1], c = sp[2], d = sp[3];
        const float s = (((a[0] + a[1]) + (a[2] + a[3])) + ((b[0] + b[1]) + (b[2] + b[3]))) + (((c[0] + c[1]) + (c[2] + c[3])) + ((d[0] + d[1]) + (d[2] + d[3])));
        const float r = 1.0f / sqrtf(s * (1.0f / DMODEL) + RMS_EPS);
#pragma unroll
        for (int j = 0; j < 4; ++j) { const f32x4 v = xr[64 * j]; xr[64 * j] = v * r * gf[j]; }
    }
}

__global__ void __launch_bounds__(NWAVES * 64, 2) fox_layer_fwd(Args args) {
    extern __shared__ __attribute__((aligned(16))) unsigned char lds[];
    Ctx F;
    F.lds = (LAS unsigned char*)lds;
    volatile LAS unsigned* MISC = (volatile LAS unsigned*)(F.lds + MISC_OFF);
    F.tid = threadIdx.x; F.lane = F.tid & 63; F.wave = __builtin_amdgcn_readfirstlane(F.tid >> 6);
    F.G = gridDim.x; { const int bx = blockIdx.x; F.vcu = (F.G % 8 == 0) ? (bx % 8) * (F.G / 8) + bx / 8 : bx; }
    F.x = args.in[0]; F.g_mix = args.in[1]; F.w_in = args.in[2]; F.b_f = args.in[3]; F.w_conv = args.in[4]; F.g_conv_out = args.in[5]; F.g_attn_out = args.in[6];
    F.w_o = args.in[7]; F.g_ffn = args.in[8]; F.w_up = args.in[9]; F.w_ffn_conv = args.in[10]; F.w_down = args.in[11]; F.g_final = args.in[12];
    F.out = args.out; F.ws = args.ws;
    gu32* ctl = (gu32*)(F.ws + WS_CTL);
    for (int u = F.tid; u < (LDS_BYTES - LDSCTL_OFF) / 4; u += NWAVES * 64) ((LAS unsigned*)(F.lds + LDSCTL_OFF))[u] = 0u;
    __syncthreads();
    XcdBarrier bar = xcd_barrier_post((unsigned*)(ctl + CW_BAR) + args.li * XCD_BAR_WORDS, MISC + 8);
    const int lo = args.ph_lo, hi = args.ph_hi;
#define IN(k) (((MEGA_MASK >> (k)) & 1) && lo <= (k) && (k) < hi)
#define BOTH(k) (IN(k) && IN((k) + 1))
#define REP(k) (((REPEAT_MASK >> (k)) & 1) ? 2 : 1)
    bf16* const WIN = (bf16*)(F.ws + WS_WIN); bf16* const WO = (bf16*)(F.ws + WS_WO); bf16* const WUP = (bf16*)(F.ws + WS_WUP); bf16* const WDN = (bf16*)(F.ws + WS_WDN);
    bf16* const H1 = (bf16*)(F.ws + WS_H1); bf16* const QKV = (bf16*)(F.ws + WS_QKV); bf16* const MIX = (bf16*)(F.ws + WS_MIX); bf16* const ACT = (bf16*)(F.ws + WS_ACT);

    if (IN(0)) { for (int rep = 0; rep < REP(0); ++rep) { if (rep) xcd_barrier(bar); p0_prologue(F); } if (BOTH(0)) xcd_barrier(bar); }

    if (IN(1)) { for (int rep = 0; rep < REP(1); ++rep) { if (rep) xcd_barrier(bar);
        if (blockIdx.x < BATCH * NHEADS) p1_scan(F, (int)blockIdx.x);
        pg8::Gemm g{H1, WIN, TOK, NMAIN, DMODEL}; pg8::StaticOrder S; S.init(TOK, NMAIN, F.G, (int)blockIdx.x);
        pg8::EpiBf16 E{QKV, CONV_CH, CONV_CH, (size_t)(QKV_STRIDE / 2), QSCALE, (unsigned*)(F.ws + WS_CTL) + CW_KN2, -1};
        pg8::gemm_phase<pg8::EpiBf16, pg8::StaticOrder, true, true>(F.lds + RING_OFF, g, S, E); }
        if (BOTH(1)) xcd_barrier(bar);
    }

    if (IN(2)) { for (int rep = 0; rep < REP(2); ++rep) { if (rep) xcd_barrier(bar);
        p2_conv(F);
        __syncthreads();
        const attn_body::AttnTensors AT{(const attn_body::bf16*)QKV, (const attn_body::bf16*)(F.ws + WS_QKV + QKV_STRIDE), (const attn_body::bf16*)(F.ws + WS_QKV + 2 * QKV_STRIDE),
                                        (const float*)(F.ws + WS_FB), (const unsigned*)(F.ws + WS_CTL) + CW_KN2, (attn_body::bf16*)MIX, (float*)(F.ws + WS_SSQA)};
        const attn_body::StaticOrder S((int)F.G, (int)blockIdx.x);
        attn_body::attn_phase<attn_body::StaticOrder>((char*)lds + RING_OFF, AT, S); }
        if (BOTH(2)) xcd_barrier(bar);
    }

    if (IN(3)) { for (int rep = 0; rep < REP(3); ++rep) { if (rep) xcd_barrier(bar);
        pg8::Gemm g{MIX, WO, TOK, DMODEL, DMODEL}; pg8::StaticOrder S; S.init(TOK, DMODEL, F.G, (int)blockIdx.x);
        pg8::EpiX1 E{F.x, F.out, H1, (float*)(F.ws + WS_SSQ1), (const float*)(F.ws + WS_SSQA), 8};
        pg8::gemm_phase<pg8::EpiX1, pg8::StaticOrder, true, true>(F.lds + RING_OFF, g, S, E); }
        if (BOTH(3)) xcd_barrier(bar);
    }

    if (IN(4)) { for (int rep = 0; rep < REP(4); ++rep) { if (rep) xcd_barrier(bar);
        pg8::Gemm g{H1, WUP, TOK, 2 * DFF, DMODEL}; pg8::StaticOrder S; S.init(TOK, 2 * DFF, F.G, (int)blockIdx.x);
        pg8::EpiUp E{ACT, (const float*)(F.ws + WS_SSQ1), F.w_ffn_conv, (float*)(F.ws + WS_HF), (float*)(F.ws + WS_HL), -1};
        pg8::gemm_phase<pg8::EpiUp, pg8::StaticOrder, true, true>(F.lds + RING_OFF, g, S, E); }
        xcd_barrier(bar);
        p4_fixup(F);
        if (BOTH(4)) xcd_barrier(bar);
    }

    if (IN(5)) {
        pg8::Gemm g{ACT, WDN, TOK, DMODEL, DFF}; pg8::StaticOrder S; S.init(TOK, DMODEL, F.G, (int)blockIdx.x);
        pg8::EpiDown E{F.out, (float*)(F.ws + WS_SSQ2), -1};
        pg8::gemm_phase<pg8::EpiDown, pg8::StaticOrder, true, true>(F.lds + RING_OFF, g, S, E);
        if (BOTH(5)) xcd_barrier(bar);
    }

    if (IN(6)) p6_final(F);
#undef IN
#undef BOTH
}

namespace nv {
__device__ __forceinline__ float bf2f(bf16 b) { return __uint_as_float((unsigned)b << 16); }
__device__ __forceinline__ bf16 f2b(float f) { return (bf16)f2bf(f); }
__device__ __forceinline__ float block_sum(float v, float* sh) {
    v = wave_sum(v); const int w = threadIdx.x >> 6; __syncthreads(); if ((threadIdx.x & 63) == 0) sh[w] = v; __syncthreads();
    return (sh[0] + sh[1]) + (sh[2] + sh[3]);
}
__global__ void __launch_bounds__(256) s0_rows(const float* x, const float* g, const float* w_in, const float* b_f, bf16* H1, float* LOGF) {
    __shared__ float sh[4]; const int row = blockIdx.x, tid = threadIdx.x; float v[4]; float ss = 0.f;
    for (int i = 0; i < 4; ++i) { v[i] = x[(size_t)row * DMODEL + tid + 256 * i]; ss += v[i] * v[i]; }
    const float rstd = 1.0f / sqrtf(block_sum(ss, sh) * (1.0f / DMODEL) + RMS_EPS);
    float part[8] = {0.f, 0.f, 0.f, 0.f, 0.f, 0.f, 0.f, 0.f};
    for (int i = 0; i < 4; ++i) { const int k = tid + 256 * i; const float h = v[i] * rstd * g[k]; H1[(size_t)row * DMODEL + k] = f2b(h);
        for (int hh = 0; hh < 8; ++hh) part[hh] += h * w_in[(size_t)k * IN_COLS + NMAIN + hh]; }
    for (int hh = 0; hh < 8; ++hh) { const float p = block_sum(part[hh], sh); if (tid == hh) LOGF[(size_t)((row / SEQ) * NHEADS + hh) * SEQ + (row % SEQ)] = log_sigmoid_f(p + b_f[hh]); }
}
__global__ void s1_scan(const float* LOGF, float* FB) { const int bh = blockIdx.x * blockDim.x + threadIdx.x; if (bh >= BATCH * NHEADS) return; float a = 0.f;
    for (int s = 0; s < SEQ; ++s) { a += LOGF[(size_t)bh * SEQ + s]; FB[(size_t)bh * SEQ + s] = -LOG2E * a; } }
__global__ void __launch_bounds__(256) s1_kn2(const bf16* K, unsigned* KN2) {
    __shared__ float sh[256]; const int bh = blockIdx.x, b = bh / NHEADS, h = bh % NHEADS; float mx = 0.f;
    for (int s = threadIdx.x; s < SEQ; s += 256) { float ss = 0.f; for (int d = 0; d < 64; ++d) { const float v = bf2f(K[((size_t)b * SEQ + s) * CONV_CH + h * 64 + d]); ss += v * v; } mx = fmaxf(mx, ss); }
    sh[threadIdx.x] = mx; __syncthreads(); if (threadIdx.x == 0) { for (int i = 1; i < 256; ++i) mx = fmaxf(mx, sh[i]); KN2[bh * 2] = __float_as_uint(mx); KN2[bh * 2 + 1] = 0u; }
}
template <class Fn> __global__ void __launch_bounds__(256) gemm(Fn f, int K) {
    __shared__ float As[16][65], Bs[16][65];
    const int tid = threadIdx.x, tx = tid & 15, ty = tid >> 4, row0 = blockIdx.y * 64, col0 = blockIdx.x * 64;
    float acc[4][4];
    for (int i = 0; i < 4; ++i) for (int j = 0; j < 4; ++j) acc[i][j] = 0.f;
    for (int k0 = 0; k0 < K; k0 += 16) {
        for (int i = 0; i < 4; ++i) { const int idx = tid + 256 * i; As[idx & 15][idx >> 4] = f.a(row0 + (idx >> 4), k0 + (idx & 15)); }
        for (int i = 0; i < 4; ++i) { const int idx = tid + 256 * i; Bs[idx >> 6][idx & 63] = f.b(k0 + (idx >> 6), col0 + (idx & 63)); }
        __syncthreads();
#pragma unroll
        for (int kk = 0; kk < 16; ++kk) { float a[4], b[4];
#pragma unroll
            for (int i = 0; i < 4; ++i) { a[i] = As[kk][ty * 4 + i]; b[i] = Bs[kk][tx * 4 + i]; }
#pragma unroll
            for (int i = 0; i < 4; ++i)
#pragma unroll
                for (int j = 0; j < 4; ++j) acc[i][j] += a[i] * b[j]; }
        __syncthreads();
    }
    for (int i = 0; i < 4; ++i) for (int j = 0; j < 4; ++j) f.epi(row0 + ty * 4 + i, col0 + tx * 4 + j, acc[i][j]);
}
struct F1 { const bf16* H1; const float* w_in; bf16* QKV;
    __device__ float a(int r, int k) const { return bf2f(H1[(size_t)r * DMODEL + k]); }
    __device__ float b(int k, int c) const { const int ar = c >> 9, j = c & 511; const int sb = (ar == 0) ? 1536 : (ar == 1) ? 2048 : (ar == 2) ? 2560 : (ar == 3) ? 0 : (ar == 4) ? 512 : 1024; return w_in[(size_t)k * IN_COLS + sb + j]; }
    __device__ void epi(int r, int c, float v) const { const int ar = c >> 9, j = c & 511; if (ar == 0) v *= QSCALE; QKV[(size_t)ar * (QKV_STRIDE / 2) + (size_t)r * CONV_CH + j] = f2b(v); } };
__global__ void __launch_bounds__(256) s2_conv(const bf16* GB, const bf16* GC, const bf16* XC, const float* w_conv, const float* gco, bf16* MIX) {
    __shared__ float sh[4]; const int t = blockIdx.x, tid = threadIdx.x, s = t % SEQ; float y[2]; float ss = 0.f;
    for (int i = 0; i < 2; ++i) { const int c = tid + 256 * i; float accv = 0.f;
        for (int j = 0; j < 3; ++j) { const int d = 2 - j; if (s - d >= 0) accv += w_conv[j * CONV_CH + c] * bf2f(GC[(size_t)(t - d) * CONV_CH + c]) * bf2f(XC[(size_t)(t - d) * CONV_CH + c]); }
        y[i] = bf2f(GB[(size_t)t * CONV_CH + c]) * accv; ss += y[i] * y[i]; }
    const float rstd = 1.0f / sqrtf(block_sum(ss, sh) * (1.0f / CONV_CH) + RMS_EPS);
    for (int i = 0; i < 2; ++i) { const int c = tid + 256 * i; MIX[(size_t)t * DMODEL + CONV_CH + c] = f2b(y[i] * rstd * gco[c]); }
}
__global__ void __launch_bounds__(64) s2_attn(const bf16* Q, const bf16* K, const bf16* V, const float* FB, bf16* MIX, float* SSQA) {
    const int bh = blockIdx.y, b = bh / NHEADS, h = bh % NHEADS, t = blockIdx.x * 64 + threadIdx.x; const size_t rb = (size_t)b * SEQ;
    float q[64], o[64];
    for (int d = 0; d < 64; ++d) { q[d] = bf2f(Q[(rb + t) * CONV_CH + h * 64 + d]); o[d] = 0.f; }
    float m = -INFINITY, l = 0.f; const int smax = blockIdx.x * 64 + 63;
    for (int s = 0; s <= smax; ++s) {
        const v4u* kr = (const v4u*)(K + (rb + s) * CONV_CH + h * 64); const v4u* vr = (const v4u*)(V + (rb + s) * CONV_CH + h * 64);
        float sc = 0.f;
#pragma unroll
        for (int c = 0; c < 8; ++c) { const v4u w = kr[c]; sc += q[8 * c] * bflo(w.x) + q[8 * c + 1] * bfhi(w.x) + q[8 * c + 2] * bflo(w.y) + q[8 * c + 3] * bfhi(w.y) + q[8 * c + 4] * bflo(w.z) + q[8 * c + 5] * bfhi(w.z) + q[8 * c + 6] * bflo(w.w) + q[8 * c + 7] * bfhi(w.w); }
        sc += FB[(size_t)bh * SEQ + s];
        if (s <= t) { const float mn = fmaxf(m, sc), f = exp2f(m - mn), p = exp2f(sc - mn); l = l * f + p; m = mn;
#pragma unroll
            for (int c = 0; c < 8; ++c) { const v4u w = vr[c];
                o[8 * c] = o[8 * c] * f + p * bflo(w.x); o[8 * c + 1] = o[8 * c + 1] * f + p * bfhi(w.x); o[8 * c + 2] = o[8 * c + 2] * f + p * bflo(w.y); o[8 * c + 3] = o[8 * c + 3] * f + p * bfhi(w.y);
                o[8 * c + 4] = o[8 * c + 4] * f + p * bflo(w.z); o[8 * c + 5] = o[8 * c + 5] * f + p * bfhi(w.z); o[8 * c + 6] = o[8 * c + 6] * f + p * bflo(w.w); o[8 * c + 7] = o[8 * c + 7] * f + p * bfhi(w.w); } }
    }
    float ss = 0.f; const float rl = 1.0f / l;
    for (int d = 0; d < 64; ++d) { const bf16 ob = f2b(o[d] * rl); MIX[(rb + t) * DMODEL + h * 64 + d] = ob; const float of = bf2f(ob); ss += of * of; }
    SSQA[(rb + t) * NHEADS + h] = ss;
}
__global__ void s3_rattn(const float* SSQA, float* RS) { const int t = blockIdx.x * blockDim.x + threadIdx.x; if (t >= TOK) return; float s = 0.f; for (int h = 0; h < 8; ++h) s += SSQA[(size_t)t * 8 + h]; RS[t] = 1.0f / sqrtf(s * (1.0f / 512.0f) + RMS_EPS); }
struct F3 { const bf16* MIX; const float* RS; const float* g_attn; const float* w_o; const float* x; float* x1; bf16* x1b;
    __device__ float a(int r, int k) const { const float v = bf2f(MIX[(size_t)r * DMODEL + k]); return k < 512 ? v * RS[r] * g_attn[k] : v; }
    __device__ float b(int k, int c) const { return k < 512 ? w_o[(size_t)(512 + k) * DMODEL + c] : w_o[(size_t)(k - 512) * DMODEL + c]; }
    __device__ void epi(int r, int c, float v) const { const float o = x[(size_t)r * DMODEL + c] + v; x1[(size_t)r * DMODEL + c] = o; x1b[(size_t)r * DMODEL + c] = f2b(o); } };
__global__ void __launch_bounds__(256) rows_ssq(const float* X, float* SSQ, float* RS) {
    __shared__ float sh[4]; const int row = blockIdx.x, tid = threadIdx.x; float ss = 0.f;
    for (int i = 0; i < 4; ++i) { const float v = X[(size_t)row * DMODEL + tid + 256 * i]; ss += v * v; }
    ss = block_sum(ss, sh); if (tid < 16) SSQ[(size_t)row * 16 + tid] = tid == 0 ? ss : 0.f; if (RS && tid == 0) RS[row] = 1.0f / sqrtf(ss * (1.0f / DMODEL) + RMS_EPS);
}
struct F4 { const bf16* X1B; const float* RS; const float* g_ffn; const float* w_up; bf16* UU; int rb;
    __device__ float a(int r, int k) const { return bf2f(X1B[(size_t)(rb + r) * DMODEL + k]); }
    __device__ float b(int k, int c) const { return g_ffn[k] * w_up[(size_t)k * (2 * DFF) + c]; }
    __device__ void epi(int r, int c, float v) const { UU[(size_t)r * (2 * DFF) + c] = f2b(v * RS[rb + r]); } };
__global__ void __launch_bounds__(256) s4_gate(const bf16* UU, const float* wc, bf16* ACT, int rb) {
    const size_t i = (size_t)blockIdx.x * 256 + threadIdx.x; if (i >= (size_t)SEQ * DFF) return; const int s = (int)(i / DFF), c = (int)(i % DFF); float ua = 0.f, ug = 0.f;
    for (int j = 0; j < 3; ++j) { const int d = 2 - j; if (s - d >= 0) { ua += wc[(size_t)j * (2 * DFF) + c] * bf2f(UU[(size_t)(s - d) * (2 * DFF) + c]); ug += wc[(size_t)j * (2 * DFF) + DFF + c] * bf2f(UU[(size_t)(s - d) * (2 * DFF) + DFF + c]); } }
    ACT[(size_t)(rb + s) * DFF + c] = f2b(ua * ug / (1.0f + expf(-ug)));
}
struct F5 { const bf16* ACT; const float* w_down; float* xio;
    __device__ float a(int r, int k) const { return bf2f(ACT[(size_t)r * DFF + k]); }
    __device__ float b(int k, int c) const { return w_down[(size_t)k * DMODEL + c]; }
    __device__ void epi(int r, int c, float v) const { xio[(size_t)r * DMODEL + c] += v; } };
__global__ void __launch_bounds__(256) s6_final(float* X, const float* SSQ2, const float* gf) {
    const int row = blockIdx.x, tid = threadIdx.x; float s = 0.f; for (int i = 0; i < 16; ++i) s += SSQ2[(size_t)row * 16 + i];
    const float r = 1.0f / sqrtf(s * (1.0f / DMODEL) + RMS_EPS);
    for (int i = 0; i < 4; ++i) { const int k = tid + 256 * i; X[(size_t)row * DMODEL + k] = X[(size_t)row * DMODEL + k] * r * gf[k]; }
}
}

extern "C" void kernel_launch(void* const* d_in, const int* in_sizes, int n_in, void* d_out, int out_size, void* d_ws, size_t ws_size, hipStream_t stream) {
    static int grid = 0;
    if (grid == 0) {
        if (n_in != 13 || in_sizes[0] != TOK * DMODEL || out_size != TOK * DMODEL || ws_size < WS_END) { fprintf(stderr, "kernel_launch: built for 13 inputs, x/out of %d floats, >= %zu bytes of workspace; got n_in %d, in0 %d, out %d, ws %zu; nothing launched\n", TOK * DMODEL, (size_t)WS_END, n_in, n_in > 0 ? in_sizes[0] : -1, out_size, ws_size); grid = -1; return; }
        int dev = 0, cus = 0, per_cu = 0;
        if (hipGetDevice(&dev) != hipSuccess || hipDeviceGetAttribute(&cus, hipDeviceAttributeMultiprocessorCount, dev) != hipSuccess) { fprintf(stderr, "kernel_launch: device query failed\n"); grid = -1; return; }
        if (hipFuncSetAttribute((const void*)fox_layer_fwd, hipFuncAttributeMaxDynamicSharedMemorySize, LDS_BYTES) != hipSuccess) { fprintf(stderr, "kernel_launch: hipFuncSetAttribute failed\n"); grid = -1; return; }
        if (hipOccupancyMaxActiveBlocksPerMultiprocessor(&per_cu, (const void*)fox_layer_fwd, NWAVES * 64, LDS_BYTES) != hipSuccess || per_cu < 1)
            fprintf(stderr, "kernel_launch: note: the occupancy query reports %d workgroups per CU\n", per_cu);
        (void)hipGetLastError();
        grid = cus;
    }
    if (grid < 0) return;
    if (hipMemsetAsync((char*)d_ws + WS_CTL, 0, CTL_ZERO_BYTES, stream) != hipSuccess) { fprintf(stderr, "kernel_launch: hipMemsetAsync failed\n"); return; }
    Args a{};
    for (int i = 0; i < 13; ++i) a.in[i] = (const float*)d_in[i];
    a.out = (float*)d_out; a.ws = (unsigned char*)d_ws;
    unsigned char* ws = (unsigned char*)d_ws; float* out = (float*)d_out;
    const float *x = a.in[0], *g_mix = a.in[1], *w_in = a.in[2], *b_f = a.in[3], *w_conv = a.in[4], *g_conv_out = a.in[5], *g_attn_out = a.in[6], *w_o = a.in[7], *g_ffn = a.in[8], *w_up = a.in[9], *w_ffn_conv = a.in[10], *w_down = a.in[11], *g_final = a.in[12];
    (void)g_mix; (void)w_in; (void)b_f; (void)w_conv; (void)g_conv_out; (void)g_attn_out; (void)w_o; (void)g_ffn; (void)w_up; (void)w_ffn_conv; (void)w_down; (void)g_final; (void)x; (void)out; (void)ws;
    int li = 0;
#if defined(PROBE_REP)
    { const int k = PROBE_REP; const int cut[4][2] = {{0, k + 1}, {k, k + 1}, {k + 1, 7}, {0, 0}};
      for (int j = 0; j < 3; ++j) { a.ph_lo = cut[j][0]; a.ph_hi = cut[j][1]; a.li = li++; hipLaunchKernelGGL(fox_layer_fwd, dim3(grid), dim3(NWAVES * 64), LDS_BYTES, stream, a); }
      return; }
#endif
    for (int s = 0; s < 7;) {
        if ((MEGA_MASK >> s) & 1) {
            int e = s; while (e < 7 && ((MEGA_MASK >> e) & 1)) ++e;
            a.ph_lo = s; a.ph_hi = e; a.li = li++;
            hipLaunchKernelGGL(fox_layer_fwd, dim3(grid), dim3(NWAVES * 64), LDS_BYTES, stream, a);
            const hipError_t le = hipPeekAtLastError();
            if (le != hipSuccess) { fprintf(stderr, "kernel_launch: launch failed: %s\n", hipGetErrorName(le)); return; }
            s = e; continue;
        }
#if MEGA_MASK != 0x7F
        bf16* H1 = (bf16*)(ws + WS_H1); bf16* QKV = (bf16*)(ws + WS_QKV); bf16* MIX = (bf16*)(ws + WS_MIX); bf16* ACT = (bf16*)(ws + WS_ACT); bf16* UU = (bf16*)(ws + WS_UU); float* RS = (float*)(ws + WS_RS);
        float* LOGF = (float*)(ws + WS_LOGF); float* FB = (float*)(ws + WS_FB); float* SSQA = (float*)(ws + WS_SSQA); float* SSQ1 = (float*)(ws + WS_SSQ1); float* SSQ2 = (float*)(ws + WS_SSQ2);
        switch (s) {
        case 0: hipLaunchKernelGGL(nv::s0_rows, dim3(TOK), dim3(256), 0, stream, x, g_mix, w_in, b_f, H1, LOGF); break;
        case 1: hipLaunchKernelGGL(nv::s1_scan, dim3(1), dim3(64), 0, stream, (const float*)LOGF, FB);
                hipLaunchKernelGGL(nv::gemm<nv::F1>, dim3(NMAIN / 64, TOK / 64), dim3(256), 0, stream, nv::F1{H1, w_in, QKV}, DMODEL);
                hipLaunchKernelGGL(nv::s1_kn2, dim3(BATCH * NHEADS), dim3(256), 0, stream, (const bf16*)(QKV + (QKV_STRIDE / 2)), (unsigned*)(ws + WS_CTL) + CW_KN2); break;
        case 2: hipLaunchKernelGGL(nv::s2_conv, dim3(TOK), dim3(256), 0, stream, (const bf16*)(QKV + 3 * (QKV_STRIDE / 2)), (const bf16*)(QKV + 4 * (QKV_STRIDE / 2)), (const bf16*)(QKV + 5 * (QKV_STRIDE / 2)), w_conv, g_conv_out, MIX);
                hipLaunchKernelGGL(nv::s2_attn, dim3(SEQ / 64, BATCH * NHEADS), dim3(64), 0, stream, (const bf16*)QKV, (const bf16*)(QKV + (QKV_STRIDE / 2)), (const bf16*)(QKV + 2 * (QKV_STRIDE / 2)), (const float*)FB, MIX, SSQA); break;
        case 3: hipLaunchKernelGGL(nv::s3_rattn, dim3(TOK / 256), dim3(256), 0, stream, (const float*)SSQA, RS);
                hipLaunchKernelGGL(nv::gemm<nv::F3>, dim3(DMODEL / 64, TOK / 64), dim3(256), 0, stream, nv::F3{MIX, RS, g_attn_out, w_o, x, out, H1}, DMODEL);
                hipLaunchKernelGGL(nv::rows_ssq, dim3(TOK), dim3(256), 0, stream, (const float*)out, SSQ1, (float*)nullptr); break;
        case 4: hipLaunchKernelGGL(nv::rows_ssq, dim3(TOK), dim3(256), 0, stream, (const float*)out, SSQ1, RS);
                for (int b = 0; b < BATCH; ++b) {
                    hipLaunchKernelGGL(nv::gemm<nv::F4>, dim3(2 * DFF / 64, SEQ / 64), dim3(256), 0, stream, nv::F4{H1, RS, g_ffn, w_up, UU, b * SEQ}, DMODEL);
                    hipLaunchKernelGGL(nv::s4_gate, dim3((unsigned)(((size_t)SEQ * DFF + 255) / 256)), dim3(256), 0, stream, (const bf16*)UU, w_ffn_conv, ACT, b * SEQ); }
                break;
        case 5: hipLaunchKernelGGL(nv::gemm<nv::F5>, dim3(DMODEL / 64, TOK / 64), dim3(256), 0, stream, nv::F5{ACT, w_down, out}, DFF);
                hipLaunchKernelGGL(nv::rows_ssq, dim3(TOK), dim3(256), 0, stream, (const float*)out, SSQ2, (float*)nullptr); break;
        case 6: hipLaunchKernelGGL(nv::s6_final, dim3(TOK), dim3(256), 0, stream, out, (const float*)SSQ2, g_final); break;
        }
#endif
        ++s;
    }
}
```
